# Optimizing an MI355X kernel written in HIP

```python
import jax, jax.numpy as jnp
from jax import lax
import numpy as np

D_MODEL = 2048
BATCH = 4
SEQ = 2048
DEPTH = 4
DEC_BATCH = 32
DEC_SEQ = 1
PAST_LEN = 16384
PAGE_SIZE = 128

N_MIXERS = 2
N_SWA_LAYERS = (DEPTH + 1) // 2
N_RET_LAYERS = DEPTH // 2
HEAD_DIM = 128
MIX_WIDTH = D_MODEL
MEM_LEN = 256
MEM_HEADS = 4
MEM_DIM = MEM_HEADS * HEAD_DIM
SELF_WIDTH = MIX_WIDTH - MEM_DIM
SWA_Q_HEADS = SELF_WIDTH // HEAD_DIM
SWA_KV_HEADS = SWA_Q_HEADS // 3
SWA_GROUP = SWA_Q_HEADS // SWA_KV_HEADS
WINDOW = 128
ROPE_THETA = 500000.0
ROPE_DIM = HEAD_DIM // 4
RET_DK = 128
RET_DV = 2 * RET_DK
RET_HEADS = SELF_WIDTH // RET_DV
RET_CHUNK = 128
RET_ROT_BASE = 10000.0
D_FF = ((8 * D_MODEL // 3 + 255) // 256) * 256
LN_EPS = 1e-5
HEAD_NORM_EPS = 1e-6
ALPHA = (2.0 * DEPTH) ** 0.25
BETA = (8.0 * DEPTH) ** -0.25
NEG_INF = -1e30

SWA_Q = SWA_Q_HEADS * HEAD_DIM
SWA_KV = SWA_KV_HEADS * HEAD_DIM
SWA_IN_WIDTH = SWA_Q + 2 * SWA_KV + MEM_DIM
SWA_OUT_WIDTH = SWA_Q + MEM_DIM
RET_QK = RET_HEADS * RET_DK
RET_V = RET_HEADS * RET_DV
RET_IN_WIDTH = 2 * RET_QK + 2 * RET_V + MEM_DIM
RET_OUT_WIDTH = RET_V + MEM_DIM

kernel_name = 'hybrid_swa_retention_memory_step'


def layer_norm(x, g, b):
    xf = x.astype(jnp.float32)
    mu = jnp.mean(xf, axis=-1, keepdims=True)
    var = jnp.mean(jnp.square(xf - mu), axis=-1, keepdims=True)
    y = (xf - mu) * lax.rsqrt(var + LN_EPS) * g.astype(jnp.float32) + b.astype(jnp.float32)
    return y.astype(x.dtype)


def swiglu(x, w_gu, w_down):
    g, u = jnp.split(x @ w_gu, 2, axis=-1)
    return (jax.nn.silu(g) * u) @ w_down


def partial_rope(x, pos):
    half = ROPE_DIM // 2
    inv = ROPE_THETA ** (-jnp.arange(half, dtype=jnp.float32) / half)
    ang = pos.astype(jnp.float32)[:, None] * inv[None, :]
    cos = jnp.cos(ang)[None, :, None, :]
    sin = jnp.sin(ang)[None, :, None, :]
    xr = x[..., :ROPE_DIM].astype(jnp.float32)
    x1, x2 = xr[..., :half], xr[..., half:]
    rot = jnp.concatenate([x1 * cos - x2 * sin, x2 * cos + x1 * sin], axis=-1).astype(x.dtype)
    return jnp.concatenate([rot, x[..., ROPE_DIM:]], axis=-1)


def retention_rotate(x, pos):
    half = RET_DK // 2
    angle = RET_ROT_BASE ** (-jnp.linspace(0.0, 1.0, half, dtype=jnp.float32))
    ang = pos.astype(jnp.float32)[:, None] * angle[None, :]
    cos = jnp.cos(ang)[None, :, None, :]
    sin = jnp.sin(ang)[None, :, None, :]
    xf = x.astype(jnp.float32).reshape(x.shape[:-1] + (half, 2))
    x1, x2 = xf[..., 0], xf[..., 1]
    out = jnp.stack([x1 * cos - x2 * sin, x2 * cos + x1 * sin], axis=-1).reshape(x.shape)
    return out.astype(x.dtype)


def sink_softmax(s, sink):
    m = jnp.maximum(jnp.max(s, axis=-1, keepdims=True), sink)
    p = jnp.exp(s - m)
    return p / (jnp.sum(p, axis=-1, keepdims=True) + jnp.exp(sink - m))


def swa_prompt(q, k, v, sinks):
    B, L = q.shape[:2]
    nb = L // WINDOW
    qb = q.reshape(B, nb, WINDOW, SWA_KV_HEADS, SWA_GROUP, HEAD_DIM)

    def band(t):
        tp = jnp.concatenate([jnp.zeros_like(t[:, :WINDOW]), t], axis=1)
        tp = tp.reshape(B, nb + 1, WINDOW, SWA_KV_HEADS, HEAD_DIM)
        return jnp.concatenate([tp[:, :-1], tp[:, 1:]], axis=2)

    kb, vb = band(k), band(v)
    s = jnp.einsum('bnqkgd,bnmkd->bnkgqm', qb, kb,
                   preferred_element_type=jnp.float32) * HEAD_DIM ** -0.5
    rel = jnp.arange(WINDOW)[:, None] + WINDOW - jnp.arange(2 * WINDOW)[None, :]
    band_ok = (rel >= 0) & (rel <= WINDOW)
    real_key = (jnp.arange(nb)[:, None, None] > 0) | (jnp.arange(2 * WINDOW)[None, None, :] >= WINDOW)
    mask = band_ok[None] & real_key
    s = jnp.where(mask[None, :, None, None], s, NEG_INF)
    sink = sinks.astype(jnp.float32).reshape(SWA_KV_HEADS, SWA_GROUP)[None, None, :, :, None, None]
    p = sink_softmax(s, sink)
    o = jnp.einsum('bnkgqm,bnmkd->bnqkgd', p.astype(vb.dtype), vb)
    return o.reshape(B, L, SWA_Q_HEADS, HEAD_DIM)


def swa_step(q, k, v, k_buf, v_buf, sinks):
    B, S = q.shape[:2]
    wb = k_buf.shape[1]
    kk = jnp.concatenate([k_buf.astype(k.dtype), k], axis=1)
    vv = jnp.concatenate([v_buf.astype(v.dtype), v], axis=1)
    qg = q.reshape(B, S, SWA_KV_HEADS, SWA_GROUP, HEAD_DIM)
    s = jnp.einsum('bqkgd,bmkd->bkgqm', qg, kk,
                   preferred_element_type=jnp.float32) * HEAD_DIM ** -0.5
    rel = jnp.arange(S)[:, None] + wb - jnp.arange(wb + S)[None, :]
    mask = (rel >= 0) & (rel <= WINDOW)
    s = jnp.where(mask, s, NEG_INF)
    sink = sinks.astype(jnp.float32).reshape(SWA_KV_HEADS, SWA_GROUP)[None, :, :, None, None]
    p = sink_softmax(s, sink)
    o = jnp.einsum('bkgqm,bmkd->bqkgd', p.astype(vv.dtype), vv)
    return o.reshape(B, S, SWA_Q_HEADS, HEAD_DIM), kk[:, S:], vv[:, S:]


def mem_attend(q, mk, mv):
    s = jnp.einsum('blhd,bmhd->bhlm', q, mk.astype(q.dtype),
                   preferred_element_type=jnp.float32) * HEAD_DIM ** -0.5
    p = jax.nn.softmax(s, axis=-1)
    return jnp.einsum('bhlm,bmhd->blhd', p.astype(q.dtype), mv.astype(q.dtype))


def retention_chunkwise(q, k, v, s0, chunk):
    B, L, H, dk = q.shape
    dv = v.shape[-1]
    nc = L // chunk
    log_g = jnp.log1p(-jnp.exp2(-5.0 - jnp.arange(H, dtype=jnp.float32)))
    n = jnp.arange(chunk, dtype=jnp.float32)
    rel = n[:, None] - n[None, :]
    decay = jnp.where(rel >= 0, jnp.exp(jnp.maximum(rel, 0.0) * log_g[:, None, None]), 0.0)
    q_dec = jnp.exp((n + 1.0) * log_g[:, None])
    k_dec = jnp.exp((chunk - 1.0 - n) * log_g[:, None])
    c_dec = jnp.exp(chunk * log_g)

    def to_chunks(t):
        return t.astype(jnp.float32).reshape(B, nc, chunk, H, t.shape[-1]).transpose(1, 0, 3, 2, 4)

    def step(state, qkv):
        qc, kc, vc = qkv
        inner = jnp.einsum('bhcd,bhmd->bhcm', qc, kc) * decay
        o = (jnp.einsum('bhcm,bhme->bhce', inner, vc)
             + jnp.einsum('bhcd,bhde->bhce', qc * q_dec[:, :, None], state))
        state = c_dec[:, None, None] * state + jnp.einsum('bhmd,bhme->bhde', kc * k_dec[:, :, None], vc)
        return state, o

    s_fin, o = lax.scan(step, s0.astype(jnp.float32), (to_chunks(q), to_chunks(k), to_chunks(v)))
    return o.transpose(1, 0, 3, 2, 4).reshape(B, L, H, dv), s_fin


def swa_mixer(h, pos, k_buf, v_buf, mk, mv, w_in, w_out, sinks):
    B, L, _ = h.shape
    q, k, v, qm = jnp.split(h @ w_in, [SWA_Q, SWA_Q + SWA_KV, SWA_Q + 2 * SWA_KV], axis=-1)
    q = partial_rope(q.reshape(B, L, SWA_Q_HEADS, HEAD_DIM), pos)
    k = partial_rope(k.reshape(B, L, SWA_KV_HEADS, HEAD_DIM), pos)
    v = v.reshape(B, L, SWA_KV_HEADS, HEAD_DIM)
    if k_buf is None:
        o = swa_prompt(q, k, v, sinks)
        wb = min(WINDOW, L)
        nk, nv = k[:, L - wb:], v[:, L - wb:]
    else:
        o, nk, nv = swa_step(q, k, v, k_buf, v_buf, sinks)
    om = mem_attend(qm.reshape(B, L, MEM_HEADS, HEAD_DIM), mk, mv)
    y = jnp.concatenate([o.reshape(B, L, SWA_Q), om.reshape(B, L, MEM_DIM)], axis=-1) @ w_out
    return y, nk, nv


def retention_mixer(h, pos, s0, mk, mv, w_in, w_out, chunk):
    B, L, _ = h.shape
    q, k, v, g, qm = jnp.split(
        h @ w_in, [RET_QK, 2 * RET_QK, 2 * RET_QK + RET_V, 2 * RET_QK + 2 * RET_V], axis=-1)
    q = retention_rotate(q.reshape(B, L, RET_HEADS, RET_DK), pos)
    k = retention_rotate(k.reshape(B, L, RET_HEADS, RET_DK), pos) * RET_DK ** -0.5
    o, s_new = retention_chunkwise(q, k, v.reshape(B, L, RET_HEADS, RET_DV), s0, chunk)
    mu = jnp.mean(o, axis=-1, keepdims=True)
    var = jnp.mean(jnp.square(o - mu), axis=-1, keepdims=True)
    o = ((o - mu) * lax.rsqrt(var + HEAD_NORM_EPS)).reshape(B, L, RET_V)
    o = (jax.nn.silu(g.astype(jnp.float32)) * o).astype(h.dtype)
    om = mem_attend(qm.reshape(B, L, MEM_HEADS, HEAD_DIM), mk, mv)
    y = jnp.concatenate([o, om.reshape(B, L, MEM_DIM)], axis=-1) @ w_out
    return y, s_new


def run_trunk(x, pos, swa_k, swa_v, ret_s, mem_k, mem_v, ln_g, ln_b, ffn_w_gu, ffn_w_down,
              swa_w_in, swa_w_out, swa_sinks, ret_w_in, ret_w_out):
    B, L, _ = x.shape
    prompt = ret_s is None
    new_k, new_v, new_s = [], [], []
    for i in range(DEPTH):
        j = i // N_MIXERS
        x = layer_norm(ALPHA * x + 0.5 * swiglu(x, ffn_w_gu[i, 0], ffn_w_down[i, 0]), ln_g[i, 0], ln_b[i, 0])
        if i % N_MIXERS == 0:
            y, nk, nv = swa_mixer(x, pos, None if prompt else swa_k[j], None if prompt else swa_v[j],
                                  mem_k[i], mem_v[i], swa_w_in[j], swa_w_out[j], swa_sinks[j])
            new_k.append(nk)
            new_v.append(nv)
        else:
            s0 = jnp.zeros((B, RET_HEADS, RET_DK, RET_DV), jnp.float32) if prompt else ret_s[j]
            chunk = min(RET_CHUNK, L) if prompt else L
            y, ns = retention_mixer(x, pos, s0, mem_k[i], mem_v[i], ret_w_in[j], ret_w_out[j], chunk)
            new_s.append(ns)
        x = layer_norm(ALPHA * x + y, ln_g[i, 1], ln_b[i, 1])
        x = layer_norm(ALPHA * x + 0.5 * swiglu(x, ffn_w_gu[i, 1], ffn_w_down[i, 1]), ln_g[i, 2], ln_b[i, 2])
    return x, jnp.stack(new_k), jnp.stack(new_v), jnp.stack(new_s)


def setup_inputs(seed: int = 0) -> dict:
    key = jax.random.key(seed)
    ks = jax.random.split(key, 20)
    f32 = jnp.float32

    def nrm(k, shape, scale=1.0):
        return jax.random.normal(k, shape, f32) * scale

    wbuf = min(WINDOW, PAST_LEN)
    return {
        'x_prompt': nrm(ks[0], (BATCH, SEQ, D_MODEL)),
        'x_sample': nrm(ks[1], (DEC_BATCH, DEC_SEQ, D_MODEL)),
        'cache_swa_k': nrm(ks[2], (N_SWA_LAYERS, DEC_BATCH, wbuf, SWA_KV_HEADS, HEAD_DIM)),
        'cache_swa_v': nrm(ks[3], (N_SWA_LAYERS, DEC_BATCH, wbuf, SWA_KV_HEADS, HEAD_DIM)),
        'state_ret': nrm(ks[4], (N_RET_LAYERS, DEC_BATCH, RET_HEADS, RET_DK, RET_DV), 0.5),
        'cache_mem_k': nrm(ks[5], (DEPTH, DEC_BATCH, MEM_LEN, MEM_HEADS, HEAD_DIM)),
        'cache_mem_v': nrm(ks[6], (DEPTH, DEC_BATCH, MEM_LEN, MEM_HEADS, HEAD_DIM)),
        'mem_prompt': nrm(ks[7], (BATCH, MEM_LEN, D_MODEL)),
        'ln_g': 1.0 + nrm(ks[8], (DEPTH, 3, D_MODEL), 0.05),
        'ln_b': nrm(ks[9], (DEPTH, 3, D_MODEL), 0.02),
        'ffn_w_gu': nrm(ks[10], (DEPTH, 2, D_MODEL, 2 * D_FF), D_MODEL ** -0.5),
        'ffn_w_down': nrm(ks[11], (DEPTH, 2, D_FF, D_MODEL), BETA * D_FF ** -0.5),
        'w_mem_kv': nrm(ks[12], (DEPTH, D_MODEL, 2 * MEM_DIM), D_MODEL ** -0.5),
        'swa_w_in': nrm(ks[13], (N_SWA_LAYERS, D_MODEL, SWA_IN_WIDTH), D_MODEL ** -0.5),
        'swa_w_out': nrm(ks[14], (N_SWA_LAYERS, SWA_OUT_WIDTH, D_MODEL), BETA * SWA_OUT_WIDTH ** -0.5),
        'swa_sinks': nrm(ks[15], (N_SWA_LAYERS, SWA_Q_HEADS), 0.5),
        'ret_w_in': nrm(ks[16], (N_RET_LAYERS, D_MODEL, RET_IN_WIDTH), D_MODEL ** -0.5),
        'ret_w_out': nrm(ks[17], (N_RET_LAYERS, RET_OUT_WIDTH, D_MODEL), BETA * RET_OUT_WIDTH ** -0.5),
    }


def reference(x_prompt, x_sample, cache_swa_k, cache_swa_v, state_ret, cache_mem_k, cache_mem_v,
              mem_prompt, ln_g, ln_b, ffn_w_gu, ffn_w_down, w_mem_kv, swa_w_in, swa_w_out,
              swa_sinks, ret_w_in, ret_w_out):
    bp = mem_prompt.shape[0]
    mem_kv = jnp.einsum('bmd,lde->lbme', mem_prompt, w_mem_kv)
    mem_k_prompt, mem_v_prompt = jnp.split(mem_kv, 2, axis=-1)
    mem_k_prompt = mem_k_prompt.reshape(DEPTH, bp, MEM_LEN, MEM_HEADS, HEAD_DIM)
    mem_v_prompt = mem_v_prompt.reshape(DEPTH, bp, MEM_LEN, MEM_HEADS, HEAD_DIM)

    pos_prompt = jnp.arange(x_prompt.shape[1], dtype=jnp.int32)
    pos_sample = PAST_LEN + jnp.arange(x_sample.shape[1], dtype=jnp.int32)

    y_prompt, swa_k_prompt, swa_v_prompt, ret_state_prompt = run_trunk(
        x_prompt, pos_prompt, None, None, None, mem_k_prompt, mem_v_prompt,
        ln_g, ln_b, ffn_w_gu, ffn_w_down, swa_w_in, swa_w_out, swa_sinks, ret_w_in, ret_w_out)
    y_sample, swa_k_sample, swa_v_sample, ret_state_sample = run_trunk(
        x_sample, pos_sample, cache_swa_k, cache_swa_v, state_ret, cache_mem_k, cache_mem_v,
        ln_g, ln_b, ffn_w_gu, ffn_w_down, swa_w_in, swa_w_out, swa_sinks, ret_w_in, ret_w_out)
    return (y_prompt, y_sample, swa_k_prompt, swa_v_prompt, swa_k_sample, swa_v_sample,
            ret_state_prompt, ret_state_sample, mem_k_prompt, mem_v_prompt)
```

```cpp
#include <hip/hip_runtime.h>
#include <cstdio>
#include <cstdint>
namespace pg8 {
#define PG8_LAS __attribute__((address_space(3)))
typedef unsigned short bf16_t;
typedef short bf16x8 __attribute__((ext_vector_type(8)));
typedef float f32x4 __attribute__((ext_vector_type(4)));
typedef unsigned u32x4 __attribute__((ext_vector_type(4)));
constexpr int BM = 256, BK = 64, HALF = 128, HTB = HALF * BK * 2  , STAGE_BYTES = 8 * HTB, NXCD = 8, WGM = 8;

__host__ __device__ __forceinline__ int lds_byte(int r, int c) { const int st = (r >> 4) * 2 + (c >> 5), rr = r & 15, cc = c & 31, ob = rr * 64 + cc * 2; return st * 1024 + (ob ^ (((ob >> 9) & 1) << 5)); }
__host__ __device__ __forceinline__ void stage_rc(int b, int& R, int& C) { const int st = b / 1024, sb = b % 1024, swz = sb ^ (((sb >> 9) & 1) << 5); R = (st >> 1) * 16 + swz / 64; C = (st & 1) * 32 + (swz % 64) / 2; }
__host__ __device__ __forceinline__ int perm32(int rho) { const int n = rho >> 4, i = rho & 15; return 8 * (i >> 2) + 4 * n + (i & 3); }

struct Unit { int pm, pn; };
struct Gemm { const bf16_t* A; const bf16_t* Bt; int M, N, K; };

struct StaticOrder {
    int nM, nN, nwg, G, c;
    __host__ __device__ void init(int M, int N, int G_, int c_) { nM = M / BM; nN = N / BM; nwg = nM * nN; G = G_; c = c_; }
    __host__ __device__ bool next(int i, Unit& u) const {
        const long L = (long)i * G + c; if (L >= nwg) return false;
        int wgid = (int)L; { const int q = nwg / NXCD, r = nwg % NXCD, xcd = wgid % NXCD, off = wgid / NXCD; wgid = (xcd < r ? xcd * (q + 1) : r * (q + 1) + (xcd - r) * q) + off; }
        const int nig = WGM * nN, gid = wgid / nig, fm = gid * WGM, gsz = (nM - fm) < WGM ? (nM - fm) : WGM;
        u.pm = fm + ((wgid % nig) % gsz); u.pn = (wgid % nig) / gsz; return true;
    }
    __device__ __forceinline__ void a_ready(const Unit&) const {}
    __device__ __forceinline__ void done(const Unit&) const {}
};

__device__ __forceinline__ unsigned cvt_pk_bf16(float lo, float hi) { unsigned r; asm volatile("v_cvt_pk_bf16_f32 %0, %1, %2" : "=v"(r) : "v"(lo), "v"(hi)); return r; }
typedef float f32x2 __attribute__((ext_vector_type(2)));
struct EpiStoreF32 {
    static constexpr bool PERM = false, AFTER_DRAIN = false;
    float* C; long ldc;
    __device__ __forceinline__ void operator()(const f32x4 (&acc)[2][2][4][2], const Unit& u, int wr, int wc, int fr, int fq) const {
        const int row0 = u.pm * BM + wr * 64 + fr, col0 = u.pn * BM + wc * 32 + 4 * fq;
#pragma unroll
        for (int ai = 0; ai < 2; ++ai)
#pragma unroll
            for (int m = 0; m < 4; ++m) { float* rowp = C + (size_t)(row0 + ai * HALF + m * 16) * ldc + col0;
#pragma unroll
                for (int bj = 0; bj < 2; ++bj)
#pragma unroll
                    for (int n = 0; n < 2; ++n) *(f32x4*)(rowp + bj * HALF + n * 16) = acc[ai][bj][m][n]; }
    }
};

template <class Epi, class Sched, bool ALIGN_EPI = false, bool SP2 = false>
__device__ __forceinline__ void gemm_phase(PG8_LAS unsigned char* lds, const Gemm g, const Sched& S, const Epi& E) {
    const int tid = threadIdx.x, wid = __builtin_amdgcn_readfirstlane(tid >> 6), lane = tid & 63, wr = wid >> 2, wc = wid & 3, fr = lane & 15, fq = lane >> 4;
    const int K = g.K, nt = K / BK;
    unsigned voffA[2], voffB[2];
#pragma unroll
    for (int i = 0; i < 2; ++i) { int R, C; stage_rc(tid * 16 + i * 8192, R, C); const int Rb = Epi::PERM ? ((R & ~31) + perm32(R & 31)) : R;
        voffA[i] = (unsigned)(R * K + C) * 2u; voffB[i] = (unsigned)(Rb * K + C) * 2u; }
    const size_t kstep = (size_t)(BK * 2);
    const size_t hstep = (size_t)HALF * K * 2;
    const size_t tstep = 2 * hstep;
    const unsigned ldsw = (unsigned)wid * 1024u;
    const int aoff = lds_byte(wr * 64 + fr, fq * 8), boff = lds_byte(wc * 32 + fr, fq * 8);
#define PG8_SA(b, h) (((b) * 2 + (h)) * HTB)
#define PG8_SB(b, h) ((4 + (b) * 2 + (h)) * HTB)
#define PG8_STAGE(bufoff, gbase, voff) do { _Pragma("unroll") for (int _i = 0; _i < 2; ++_i) \
        __builtin_amdgcn_global_load_lds((const unsigned*)((const char*)(gbase) + (voff)[_i]), (PG8_LAS unsigned*)(lds + (bufoff) + ldsw + _i * 8192), 16, 0, 0); } while (0)
#define PG8_LDA(dst, b, h) do { _Pragma("unroll") for (int m = 0; m < 4; ++m) _Pragma("unroll") for (int k = 0; k < 2; ++k) dst[m][k] = *(const PG8_LAS bf16x8*)(lds + PG8_SA(b, h) + aoff + m * 2048 + k * 1024); } while (0)
#define PG8_LDB(dst, b, h) do { _Pragma("unroll") for (int n = 0; n < 2; ++n) _Pragma("unroll") for (int k = 0; k < 2; ++k) dst[n][k] = *(const PG8_LAS bf16x8*)(lds + PG8_SB(b, h) + boff + n * 2048 + k * 1024); } while (0)
#define PG8_MMA(ai, bj, At, Bt) do { __builtin_amdgcn_s_setprio(1); _Pragma("unroll") for (int m = 0; m < 4; ++m) _Pragma("unroll") for (int n = 0; n < 2; ++n) _Pragma("unroll") for (int k = 0; k < 2; ++k) \
        acc[ai][bj][m][n] = __builtin_amdgcn_mfma_f32_16x16x32_bf16(Bt[n][k], At[m][k], acc[ai][bj][m][n], 0, 0, 0); __builtin_amdgcn_s_setprio(0); } while (0)
#define PG8_WAIT_V(n) asm volatile("s_waitcnt vmcnt(" #n ")" ::: "memory")
#define PG8_WAIT_L(n) asm volatile("s_waitcnt lgkmcnt(" #n ")" ::: "memory")
#define PG8_BAR __builtin_amdgcn_s_barrier()
#define PG8_SCHED __builtin_amdgcn_sched_barrier(0)
    Unit cur, nxt; int ui = 0;
    if (!S.next(0, cur)) return;
    f32x4 acc[2][2][4][2];
#pragma unroll
    for (int a = 0; a < 2; ++a)
#pragma unroll
        for (int b = 0; b < 2; ++b)
#pragma unroll
            for (int m = 0; m < 4; ++m)
#pragma unroll
                for (int n = 0; n < 2; ++n) acc[a][b][m][n] = (f32x4){0.f, 0.f, 0.f, 0.f};
    bf16x8 At[4][2], B0[2][2], B1[2][2];
    const char* cA = (const char*)g.A + (size_t)cur.pm * tstep; const char* cB = (const char*)g.Bt + (size_t)cur.pn * tstep;
    S.a_ready(cur);
    if constexpr (SP2) {
        PG8_STAGE(PG8_SB(0, 0), cB, voffB); PG8_STAGE(PG8_SB(0, 1), cB + hstep, voffB); PG8_STAGE(PG8_SA(0, 0), cA, voffA); PG8_STAGE(PG8_SA(0, 1), cA + hstep, voffA);
        if (wr == 1) PG8_BAR;
        PG8_WAIT_V(2); PG8_BAR;
        PG8_STAGE(PG8_SB(1, 0), cB + kstep, voffB); PG8_STAGE(PG8_SA(1, 0), cA + kstep, voffA); PG8_STAGE(PG8_SB(1, 1), cB + hstep + kstep, voffB);
        PG8_WAIT_V(6); PG8_BAR;
    } else {
        PG8_STAGE(PG8_SB(0, 0), cB, voffB); PG8_STAGE(PG8_SA(0, 0), cA, voffA); PG8_STAGE(PG8_SB(0, 1), cB + hstep, voffB); PG8_STAGE(PG8_SA(0, 1), cA + hstep, voffA);
        if (wr == 1) PG8_BAR;
        PG8_WAIT_V(4); PG8_BAR;
        PG8_STAGE(PG8_SB(1, 0), cB + kstep, voffB); PG8_STAGE(PG8_SA(1, 0), cA + kstep, voffA); PG8_STAGE(PG8_SB(1, 1), cB + hstep + kstep, voffB);
        PG8_WAIT_V(6); PG8_BAR;
    }
    for (;;) {
        const bool has_next = S.next(ui + 1, nxt);
        const char* nA = has_next ? (const char*)g.A + (size_t)nxt.pm * tstep : cA; const char* nB = has_next ? (const char*)g.Bt + (size_t)nxt.pn * tstep : cB;
        for (int t = 0; t < nt; t += 2) {
            const bool last = (t == nt - 2);
            const char* a1 = cA + (size_t)(t + 1) * kstep;
            const char* a2 = last ? nA : cA + (size_t)(t + 2) * kstep; const char* b2 = last ? nB : cB + (size_t)(t + 2) * kstep;
            const char* a3 = a2 + kstep; const char* b3 = b2 + kstep;
            if (last && has_next) S.a_ready(nxt);
            if constexpr (SP2) {
            PG8_LDB(B0, 0, 0); PG8_LDB(B1, 0, 1); PG8_SCHED; PG8_LDA(At, 0, 0); PG8_STAGE(PG8_SA(1, 1), a1 + hstep, voffA);
            PG8_WAIT_V(8); PG8_WAIT_L(0); PG8_BAR; PG8_MMA(0, 0, At, B0); PG8_MMA(0, 1, At, B1); PG8_BAR; PG8_SCHED;
            PG8_LDA(At, 0, 1); PG8_STAGE(PG8_SB(0, 0), b2, voffB); PG8_STAGE(PG8_SB(0, 1), b2 + hstep, voffB); PG8_STAGE(PG8_SA(0, 0), a2, voffA);
            PG8_WAIT_V(8); PG8_WAIT_L(0); PG8_BAR; PG8_MMA(1, 0, At, B0); PG8_MMA(1, 1, At, B1); PG8_BAR; PG8_SCHED;
            PG8_LDB(B0, 1, 0); PG8_LDB(B1, 1, 1); PG8_SCHED; PG8_LDA(At, 1, 0); PG8_STAGE(PG8_SA(0, 1), a2 + hstep, voffA);
            PG8_WAIT_V(8); PG8_WAIT_L(0); PG8_BAR; PG8_MMA(0, 0, At, B0); PG8_MMA(0, 1, At, B1); PG8_BAR; PG8_SCHED;
            PG8_LDA(At, 1, 1); PG8_STAGE(PG8_SB(1, 0), b3, voffB); PG8_STAGE(PG8_SB(1, 1), b3 + hstep, voffB); PG8_STAGE(PG8_SA(1, 0), a3, voffA);
            PG8_WAIT_V(8); PG8_WAIT_L(0); PG8_BAR; PG8_MMA(1, 0, At, B0); PG8_MMA(1, 1, At, B1); PG8_BAR; PG8_SCHED;
            } else {
            PG8_LDB(B0, 0, 0); PG8_SCHED; PG8_LDA(At, 0, 0); PG8_STAGE(PG8_SA(1, 1), a1 + hstep, voffA);
            PG8_WAIT_L(8); PG8_BAR; PG8_WAIT_L(0); PG8_MMA(0, 0, At, B0); PG8_BAR; PG8_SCHED;
            PG8_LDB(B1, 0, 1); PG8_STAGE(PG8_SB(0, 0), b2, voffB);
            PG8_BAR; PG8_WAIT_L(0); PG8_MMA(0, 1, At, B1); PG8_BAR;
            PG8_LDA(At, 0, 1); PG8_STAGE(PG8_SA(0, 0), a2, voffA);
            PG8_BAR; PG8_WAIT_L(0); PG8_MMA(1, 0, At, B0); PG8_BAR; PG8_SCHED;
            PG8_STAGE(PG8_SB(0, 1), b2 + hstep, voffB);
            PG8_WAIT_V(6); PG8_BAR; PG8_MMA(1, 1, At, B1); PG8_BAR;
            PG8_LDB(B0, 1, 0); PG8_SCHED; PG8_LDA(At, 1, 0); PG8_STAGE(PG8_SA(0, 1), a2 + hstep, voffA);
            PG8_WAIT_L(8); PG8_BAR; PG8_WAIT_L(0); PG8_MMA(0, 0, At, B0); PG8_BAR; PG8_SCHED;
            PG8_LDB(B1, 1, 1); PG8_STAGE(PG8_SB(1, 0), b3, voffB);
            PG8_BAR; PG8_WAIT_L(0); PG8_MMA(0, 1, At, B1); PG8_BAR;
            PG8_LDA(At, 1, 1); PG8_STAGE(PG8_SA(1, 0), a3, voffA);
            PG8_BAR; PG8_WAIT_L(0); PG8_MMA(1, 0, At, B0); PG8_BAR; PG8_SCHED;
            PG8_STAGE(PG8_SB(1, 1), b3 + hstep, voffB);
            PG8_WAIT_V(6); PG8_BAR; PG8_MMA(1, 1, At, B1); PG8_BAR;
            }
        }
        if constexpr (ALIGN_EPI) { if (wr == 0) PG8_BAR; }
        if constexpr (!Epi::AFTER_DRAIN) { E(acc, cur, wr, wc, fr, fq); S.done(cur); }
        if (!has_next) break;
#pragma unroll
        for (int a = 0; a < 2; ++a)
#pragma unroll
            for (int b = 0; b < 2; ++b)
#pragma unroll
                for (int m = 0; m < 4; ++m)
#pragma unroll
                    for (int n = 0; n < 2; ++n) acc[a][b][m][n] = (f32x4){0.f, 0.f, 0.f, 0.f};
        cur = nxt; cA = nA; cB = nB; ++ui;
        if constexpr (ALIGN_EPI) { if (wr == 1) PG8_BAR; }
    }
    PG8_WAIT_V(0);
    if constexpr (!ALIGN_EPI) { if (wr == 0) PG8_BAR; }
    PG8_BAR;
    if constexpr (Epi::AFTER_DRAIN) { E.fused(acc, cur, wr, wc, fr, fq, lds, wid, lane); S.done(cur); }
#undef PG8_SA
#undef PG8_SB
#undef PG8_STAGE
#undef PG8_LDA
#undef PG8_LDB
#undef PG8_MMA
#undef PG8_WAIT_V
#undef PG8_WAIT_L
#undef PG8_BAR
#undef PG8_SCHED
}
}

constexpr int D = 2048, DFF = 5632, NGU = 2 * DFF, NB = 4, SEQ = 2048, MP = NB * SEQ, SB = 32, MR = MP + SB, MT = 8448;
constexpr int DEPTH = 4, PAST = 16384;
constexpr int SWA_IN = 3072, RET_IN = 5120;
constexpr float LN_EPS = 1e-5f, HN_EPS = 1e-6f;
constexpr float ALPHA = 1.6817928305074292f;
constexpr float QSCALE = 0.08838834764831845f;

typedef unsigned short bf16;
#define LAS __attribute__((address_space(3)))
__device__ __forceinline__ unsigned f2bf(float f) { unsigned u = __builtin_bit_cast(unsigned, f); return (u + 0x7fffu + ((u >> 16) & 1u)) >> 16; }
__device__ __forceinline__ unsigned pk2(float lo, float hi) { return f2bf(lo) | (f2bf(hi) << 16); }
__device__ __forceinline__ float wave_sum(float v) {
#pragma unroll
    for (int o = 1; o < 64; o <<= 1) v += __shfl_xor(v, o);
    return v;
}
__device__ __forceinline__ float silu_f(float x) { return x / (1.0f + __expf(-x)); }

constexpr size_t al(size_t x) { return (x + 255) & ~(size_t)255; }
constexpr size_t WS_CTL = 0, CTL_BYTES = 1u << 20;
constexpr size_t SZ_WGU = (size_t)NGU * D * 2, SZ_WDN = (size_t)D * DFF * 2, SZ_WINS = (size_t)SWA_IN * D * 2, SZ_WINR = (size_t)RET_IN * D * 2, SZ_WOUT = (size_t)D * D * 2;
constexpr size_t WS_WGU = WS_CTL + CTL_BYTES;
constexpr size_t WS_WDN = WS_WGU + 8 * SZ_WGU;
constexpr size_t WS_WINS = WS_WDN + 8 * SZ_WDN;
constexpr size_t WS_WINR = WS_WINS + 2 * SZ_WINS;
constexpr size_t WS_WOUT = WS_WINR + 2 * SZ_WINR;
constexpr size_t WS_WMEM = WS_WOUT + 4 * SZ_WOUT;
constexpr size_t WS_XMEMB = WS_WMEM + (size_t)4096 * D * 2;
constexpr size_t WS_MEMKV = WS_XMEMB + (size_t)1024 * D * 2;
constexpr size_t WS_X = WS_MEMKV + (size_t)1024 * 4096 * 4;
constexpr size_t WS_XN = WS_X + (size_t)MT * D * 4;
constexpr size_t WS_GU = WS_XN + (size_t)MT * D * 2;
constexpr size_t WS_H = WS_GU + (size_t)MT * NGU * 4;
constexpr size_t WS_Y = WS_H + (size_t)MT * DFF * 2;
constexpr size_t WS_QKV = WS_Y + (size_t)MT * D * 4;
constexpr size_t WS_ORAW = WS_QKV + (size_t)MT * RET_IN * 4;
constexpr size_t WS_OCAT = WS_ORAW + (size_t)MT * 1536 * 4;
constexpr size_t WS_END = WS_OCAT + (size_t)MT * D * 2;

constexpr size_t O_YP = 0, O_YS = O_YP + (size_t)MP * D, O_SKP = O_YS + (size_t)SB * D, O_SVP = O_SKP + 2 * 4 * 128 * 512, O_SKS = O_SVP + 2 * 4 * 128 * 512,
                 O_SVS = O_SKS + (size_t)2 * 32 * 128 * 512, O_RSP = O_SVS + (size_t)2 * 32 * 128 * 512, O_RSS = O_RSP + (size_t)2 * 4 * 6 * 128 * 256,
                 O_MK = O_RSS + (size_t)2 * 32 * 6 * 128 * 256, O_MV = O_MK + (size_t)4 * 4 * 256 * 512, O_END = O_MV + (size_t)4 * 4 * 256 * 512;

struct GemmArgs { const bf16* A; const bf16* Bt; float* C; long ldc; int M, N, K, pad; };
__global__ void __launch_bounds__(512, 2) k_gemm_f32(GemmArgs a) {
    extern __shared__ __attribute__((aligned(16))) unsigned char shm[];
    pg8::Gemm g; g.A = a.A; g.Bt = a.Bt; g.M = a.M; g.N = a.N; g.K = a.K;
    pg8::StaticOrder S; S.init(a.M, a.N, (int)gridDim.x, (int)blockIdx.x);
    pg8::EpiStoreF32 E; E.C = a.C; E.ldc = a.ldc;
    pg8::gemm_phase<pg8::EpiStoreF32, pg8::StaticOrder, true, true>((PG8_LAS unsigned char*)shm, g, S, E);
}

__global__ void __launch_bounds__(256) k_conv_w(const float* W, int K, int pitch, int col0, int ncols, bf16* WT, int row_off) {
    __shared__ float scr_all[4][64 * 33];
    const int lane = threadIdx.x & 63, wave = threadIdx.x >> 6;
    float* scr = scr_all[wave];
    const int nblk = ncols / 32, nitems = (K / 64) * nblk;
    for (int item = blockIdx.x * 4 + wave; item < nitems; item += gridDim.x * 4) {
        const int kb = item / nblk, nb = item % nblk, k0 = 64 * kb, n0 = 32 * nb;
#pragma unroll 8
        for (int i = 0; i < 32; ++i) { const int kk = 2 * i + (lane >> 5); scr[kk * 33 + (lane & 31)] = W[(size_t)(k0 + kk) * pitch + col0 + n0 + (lane & 31)]; }
        asm volatile("s_waitcnt lgkmcnt(0)" ::: "memory");
        const int c = lane & 7;
#pragma unroll
        for (int j = 0; j < 4; ++j) { const int n = (lane >> 3) + 8 * j; const float* s = scr + (8 * c) * 33 + n;
            uint4 o; o.x = pk2(s[0 * 33], s[1 * 33]); o.y = pk2(s[2 * 33], s[3 * 33]); o.z = pk2(s[4 * 33], s[5 * 33]); o.w = pk2(s[6 * 33], s[7 * 33]);
            *(uint4*)(WT + (size_t)(row_off + n0 + n) * K + k0 + 8 * c) = o; }
        asm volatile("s_waitcnt lgkmcnt(0)" ::: "memory");
    }
}
__global__ void k_cast(const float* src, float* dstf, bf16* dstb, size_t n4) {
    for (size_t i = (size_t)blockIdx.x * blockDim.x + threadIdx.x; i < n4; i += (size_t)gridDim.x * blockDim.x) {
        const float4 v = ((const float4*)src)[i];
        if (dstf) ((float4*)dstf)[i] = v;
        uint2 o; o.x = pk2(v.x, v.y); o.y = pk2(v.z, v.w); ((uint2*)dstb)[i] = o;
    }
}
__global__ void k_mem_scatter(const float* MEMKV, float* out) {
    const size_t n = (size_t)1024 * 4096;
    for (size_t i = (size_t)blockIdx.x * blockDim.x + threadIdx.x; i < n; i += (size_t)gridDim.x * blockDim.x) {
        const int r = (int)(i / 4096), c = (int)(i % 4096), l = c / 1024, e = c % 1024;
        const float v = MEMKV[i];
        if (e < 512) out[O_MK + ((size_t)l * 1024 + r) * 512 + e] = v; else out[O_MV + ((size_t)l * 1024 + r) * 512 + (e - 512)] = v;
    }
}
__global__ void k_silu_mul(const float* GU, bf16* H, int rows) {
    const size_t n = (size_t)rows * (DFF / 4);
    for (size_t i = (size_t)blockIdx.x * blockDim.x + threadIdx.x; i < n; i += (size_t)gridDim.x * blockDim.x) {
        const size_t r = i / (DFF / 4), c4 = i % (DFF / 4);
        const float4 g = *(const float4*)(GU + r * NGU + 4 * c4), u = *(const float4*)(GU + r * NGU + DFF + 4 * c4);
        uint2 o; o.x = pk2(silu_f(g.x) * u.x, silu_f(g.y) * u.y); o.y = pk2(silu_f(g.z) * u.z, silu_f(g.w) * u.w);
        *(uint2*)(H + r * DFF + 4 * c4) = o;
    }
}
__global__ void __launch_bounds__(256) k_ln_res(float* X, const float* Y, float s, const float* g, const float* b, bf16* XN, int rows) {
    const int lane = threadIdx.x & 63;
    for (int r = blockIdx.x * 4 + (threadIdx.x >> 6); r < rows; r += gridDim.x * 4) {
        float4 v[8]; float sum = 0.f;
#pragma unroll
        for (int j = 0; j < 8; ++j) { const int c = 4 * (lane + 64 * j); const float4 x = *(const float4*)(X + (size_t)r * D + c), y = *(const float4*)(Y + (size_t)r * D + c);
            v[j].x = ALPHA * x.x + s * y.x; v[j].y = ALPHA * x.y + s * y.y; v[j].z = ALPHA * x.z + s * y.z; v[j].w = ALPHA * x.w + s * y.w;
            sum += (v[j].x + v[j].y) + (v[j].z + v[j].w); }
        const float mean = wave_sum(sum) * (1.f / D); float sq = 0.f;
#pragma unroll
        for (int j = 0; j < 8; ++j) { v[j].x -= mean; v[j].y -= mean; v[j].z -= mean; v[j].w -= mean; sq += (v[j].x * v[j].x + v[j].y * v[j].y) + (v[j].z * v[j].z + v[j].w * v[j].w); }
        const float rstd = 1.0f / sqrtf(wave_sum(sq) * (1.f / D) + LN_EPS);
#pragma unroll
        for (int j = 0; j < 8; ++j) { const int c = 4 * (lane + 64 * j); const float4 gg = *(const float4*)(g + c), bb = *(const float4*)(b + c);
            float4 o; o.x = v[j].x * rstd * gg.x + bb.x; o.y = v[j].y * rstd * gg.y + bb.y; o.z = v[j].z * rstd * gg.z + bb.z; o.w = v[j].w * rstd * gg.w + bb.w;
            *(float4*)(X + (size_t)r * D + c) = o; uint2 p; p.x = pk2(o.x, o.y); p.y = pk2(o.z, o.w); *(uint2*)(XN + (size_t)r * D + c) = p; }
    }
}
__device__ __forceinline__ float row_pos(int r) { return r < MP ? (float)(r % SEQ) : (float)PAST; }
__global__ void k_rope(float* QKV, int rows) {
    const size_t n = (size_t)rows * 16 * 16;
    for (size_t i = (size_t)blockIdx.x * blockDim.x + threadIdx.x; i < n; i += (size_t)gridDim.x * blockDim.x) {
        const int r = (int)(i / 256), hh = (int)((i / 16) % 16), ii = (int)(i % 16);
        const int col = (hh < 12 ? hh * 128 : 1536 + (hh - 12) * 128) + ii;
        const float inv = powf(500000.0f, -(float)ii / 16.0f), ang = row_pos(r) * inv;
        float sn, cs; sincosf(ang, &sn, &cs);
        float* p = QKV + (size_t)r * SWA_IN + col; const float x1 = p[0], x2 = p[16];
        p[0] = x1 * cs - x2 * sn; p[16] = x2 * cs + x1 * sn;
    }
}
__global__ void k_ret_rot(float* QKV, int rows) {
    const size_t n = (size_t)rows * 12 * 64;
    for (size_t i = (size_t)blockIdx.x * blockDim.x + threadIdx.x; i < n; i += (size_t)gridDim.x * blockDim.x) {
        const int r = (int)(i / 768), hh = (int)((i / 64) % 12), ii = (int)(i % 64);
        const int col = (hh < 6 ? hh * 128 : 768 + (hh - 6) * 128) + 2 * ii;
        const float a = powf(10000.0f, -((float)ii / 63.0f)), ang = row_pos(r) * a;
        float sn, cs; sincosf(ang, &sn, &cs);
        const float sc = hh < 6 ? 1.0f : QSCALE;
        float* p = QKV + (size_t)r * RET_IN + col; const float x1 = p[0], x2 = p[1];
        p[0] = (x1 * cs - x2 * sn) * sc; p[1] = (x2 * cs + x1 * sn) * sc;
    }
}
__device__ __forceinline__ float2 attn_row(float2 q, const float* kp, size_t ks, const float* vp, size_t vs, int nk, const float* kx, const float* vx, bool has_sink, float sink) {
    float m = has_sink ? sink : -1e30f, l = has_sink ? 1.0f : 0.0f; float2 acc = make_float2(0.f, 0.f);
    const int tot = nk + (kx ? 1 : 0);
    for (int j = 0; j < tot; ++j) {
        const float2 k = *(const float2*)(j < nk ? kp + (size_t)j * ks : kx), v = *(const float2*)(j < nk ? vp + (size_t)j * vs : vx);
        const float s = wave_sum(q.x * k.x + q.y * k.y) * QSCALE;
        const float mn = fmaxf(m, s), al = __expf(m - mn), p = __expf(s - mn);
        l = l * al + p; acc.x = acc.x * al + p * v.x; acc.y = acc.y * al + p * v.y; m = mn;
    }
    const float il = 1.0f / l; return make_float2(acc.x * il, acc.y * il);
}
__global__ void __launch_bounds__(256) k_attn_swa_prompt(const float* QKV, const float* sinks, bf16* OCAT) {
    const int lane = threadIdx.x & 63; const int nw = NB * 12 * SEQ;
    for (int w = blockIdx.x * 4 + (threadIdx.x >> 6); w < nw; w += gridDim.x * 4) {
        const int t = w % SEQ, hd = (w / SEQ) % 12, b = w / (SEQ * 12), kvh = hd / 3;
        const size_t row = (size_t)b * SEQ + t; const int j0 = t - 128 > 0 ? t - 128 : 0;
        const float2 q = *(const float2*)(QKV + row * SWA_IN + hd * 128 + 2 * lane);
        const float* kp = QKV + ((size_t)b * SEQ + j0) * SWA_IN + 1536 + kvh * 128 + 2 * lane;
        const float2 o = attn_row(q, kp, SWA_IN, kp + 512, SWA_IN, t - j0 + 1, nullptr, nullptr, true, sinks[hd]);
        *(unsigned*)(OCAT + row * D + hd * 128 + 2 * lane) = pk2(o.x, o.y);
    }
}
__global__ void __launch_bounds__(256) k_attn_mem_prompt(const float* QKV, int pitch, int qoff, const float* MK, const float* MV, bf16* OCAT) {
    const int lane = threadIdx.x & 63; const int nw = NB * 4 * SEQ;
    for (int w = blockIdx.x * 4 + (threadIdx.x >> 6); w < nw; w += gridDim.x * 4) {
        const int t = w % SEQ, h = (w / SEQ) % 4, b = w / (SEQ * 4);
        const size_t row = (size_t)b * SEQ + t;
        const float2 q = *(const float2*)(QKV + row * pitch + qoff + h * 128 + 2 * lane);
        const size_t ko = ((size_t)b * 256) * 512 + h * 128 + 2 * lane;
        const float2 o = attn_row(q, MK + ko, 512, MV + ko, 512, 256, nullptr, nullptr, false, 0.f);
        *(unsigned*)(OCAT + row * D + 1536 + h * 128 + 2 * lane) = pk2(o.x, o.y);
    }
}
__global__ void __launch_bounds__(256) k_attn_swa_sample(const float* QKV, const float* CK, const float* CV, const float* sinks, bf16* OCAT) {
    const int lane = threadIdx.x & 63; const int w = blockIdx.x * 4 + (threadIdx.x >> 6);
    if (w >= SB * 12) return;
    const int hd = w % 12, b = w / 12, kvh = hd / 3; const size_t row = (size_t)MP + b;
    const float2 q = *(const float2*)(QKV + row * SWA_IN + hd * 128 + 2 * lane);
    const size_t co = ((size_t)b * 128) * 512 + kvh * 128 + 2 * lane;
    const float* kx = QKV + row * SWA_IN + 1536 + kvh * 128 + 2 * lane;
    const float2 o = attn_row(q, CK + co, 512, CV + co, 512, 128, kx, kx + 512, true, sinks[hd]);
    *(unsigned*)(OCAT + row * D + hd * 128 + 2 * lane) = pk2(o.x, o.y);
}
__global__ void __launch_bounds__(256) k_attn_mem_sample(const float* QKV, int pitch, int qoff, const float* CMK, const float* CMV, bf16* OCAT) {
    const int lane = threadIdx.x & 63; const int w = blockIdx.x * 4 + (threadIdx.x >> 6);
    if (w >= SB * 4) return;
    const int h = w % 4, b = w / 4; const size_t row = (size_t)MP + b;
    const float2 q = *(const float2*)(QKV + row * pitch + qoff + h * 128 + 2 * lane);
    const size_t co = ((size_t)b * 256) * 512 + h * 128 + 2 * lane;
    const float2 o = attn_row(q, CMK + co, 512, CMV + co, 512, 256, nullptr, nullptr, false, 0.f);
    *(unsigned*)(OCAT + row * D + 1536 + h * 128 + 2 * lane) = pk2(o.x, o.y);
}
__global__ void k_swa_cache_out(const float* QKV, const float* CK, const float* CV, float* out, int jl) {
    const size_t np = (size_t)NB * 128 * 512, ns = (size_t)SB * 128 * 512;
    for (size_t i = (size_t)blockIdx.x * blockDim.x + threadIdx.x; i < np + ns; i += (size_t)gridDim.x * blockDim.x) {
        if (i < np) { const int e = (int)(i % 512), p = (int)((i / 512) % 128), b = (int)(i / (512 * 128));
            const float* src = QKV + ((size_t)b * SEQ + (SEQ - 128) + p) * SWA_IN + 1536 + e;
            out[O_SKP + (size_t)jl * np + i] = src[0]; out[O_SVP + (size_t)jl * np + i] = src[512]; }
        else { const size_t k = i - np; const int e = (int)(k % 512), p = (int)((k / 512) % 128), b = (int)(k / (512 * 128));
            float kv, vv;
            if (p < 127) { kv = CK[k + 512]; vv = CV[k + 512]; } else { const float* src = QKV + ((size_t)MP + b) * SWA_IN + 1536 + e; kv = src[0]; vv = src[512]; }
            out[O_SKS + (size_t)jl * ns + k] = kv; out[O_SVS + (size_t)jl * ns + k] = vv; }
    }
}
__global__ void __launch_bounds__(256) k_ret_seq(const float* QKV, int row0, int T, const float* S0, float* Sout, float* ORAW) {
    __shared__ float qs[128], ks[128];
    const int seq = blockIdx.x / 6, h = blockIdx.x % 6, dv = threadIdx.x;
    const float gamma = 1.0f - exp2f(-5.0f - (float)h);
    float S[128];
    const size_t so = ((size_t)(seq * 6 + h) * 128) * 256 + dv;
#pragma unroll
    for (int i = 0; i < 128; ++i) S[i] = S0 ? S0[so + (size_t)i * 256] : 0.f;
    for (int t = 0; t < T; ++t) {
        const size_t row = (size_t)row0 + (size_t)seq * T + t; const float* p = QKV + row * RET_IN;
        if (dv < 128) qs[dv] = p[h * 128 + dv]; else ks[dv - 128] = p[768 + h * 128 + (dv - 128)];
        const float v = p[1536 + h * 256 + dv];
        __syncthreads();
        float o = 0.f;
#pragma unroll
        for (int i = 0; i < 128; ++i) { S[i] = gamma * S[i] + ks[i] * v; o += qs[i] * S[i]; }
        ORAW[row * 1536 + h * 256 + dv] = o;
        __syncthreads();
    }
#pragma unroll
    for (int i = 0; i < 128; ++i) Sout[so + (size_t)i * 256] = S[i];
}
__global__ void __launch_bounds__(256) k_headnorm_gate(const float* ORAW, const float* QKV, bf16* OCAT, int rows) {
    const int lane = threadIdx.x & 63; const int nw = rows * 6;
    for (int w = blockIdx.x * 4 + (threadIdx.x >> 6); w < nw; w += gridDim.x * 4) {
        const int h = w % 6; const size_t row = w / 6;
        const float4 o = *(const float4*)(ORAW + row * 1536 + h * 256 + 4 * lane);
        const float mean = wave_sum((o.x + o.y) + (o.z + o.w)) * (1.f / 256.f);
        const float dx = o.x - mean, dy = o.y - mean, dz = o.z - mean, dw = o.w - mean;
        const float rstd = 1.0f / sqrtf(wave_sum((dx * dx + dy * dy) + (dz * dz + dw * dw)) * (1.f / 256.f) + HN_EPS);
        const float4 g = *(const float4*)(QKV + row * RET_IN + 3072 + h * 256 + 4 * lane);
        uint2 p; p.x = pk2(silu_f(g.x) * dx * rstd, silu_f(g.y) * dy * rstd); p.y = pk2(silu_f(g.z) * dz * rstd, silu_f(g.w) * dw * rstd);
        *(uint2*)(OCAT + row * D + h * 256 + 4 * lane) = p;
    }
}

static void launch_gemm(hipStream_t st, const bf16* A, const bf16* Bt, float* C, long ldc, int M, int N, int K) {
    GemmArgs a{}; a.A = A; a.Bt = Bt; a.C = C; a.ldc = ldc; a.M = M; a.N = N; a.K = K; a.pad = 0;
    hipLaunchKernelGGL(k_gemm_f32, dim3(256), dim3(512), 131072, st, a);
}
extern "C" void kernel_launch(void* const* d_in, const int* in_sizes, int n_in, void* d_out, int out_size, void* d_ws, size_t ws_size, hipStream_t stream) {
    static int init = 0;
    if (!init) {
        if (n_in != 18 || (size_t)out_size != O_END || ws_size < WS_END) { fprintf(stderr, "kernel_launch: unexpected sizes n_in %d out %d ws %zu (need %zu)\n", n_in, out_size, ws_size, (size_t)WS_END); init = -1; return; }
        if (hipFuncSetAttribute((const void*)k_gemm_f32, hipFuncAttributeMaxDynamicSharedMemorySize, 131072) != hipSuccess) { fprintf(stderr, "kernel_launch: hipFuncSetAttribute failed\n"); init = -1; return; }
        init = 1;
    }
    if (init < 0) return;
    const float* x_prompt = (const float*)d_in[0]; const float* x_sample = (const float*)d_in[1];
    const float* cache_swa_k = (const float*)d_in[2]; const float* cache_swa_v = (const float*)d_in[3]; const float* state_ret = (const float*)d_in[4];
    const float* cache_mem_k = (const float*)d_in[5]; const float* cache_mem_v = (const float*)d_in[6]; const float* mem_prompt = (const float*)d_in[7];
    const float* ln_g = (const float*)d_in[8]; const float* ln_b = (const float*)d_in[9]; const float* w_gu = (const float*)d_in[10]; const float* w_dn = (const float*)d_in[11];
    const float* w_mem = (const float*)d_in[12]; const float* swa_w_in = (const float*)d_in[13]; const float* swa_w_out = (const float*)d_in[14]; const float* swa_sinks = (const float*)d_in[15];
    const float* ret_w_in = (const float*)d_in[16]; const float* ret_w_out = (const float*)d_in[17];
    float* out = (float*)d_out; unsigned char* ws = (unsigned char*)d_ws;
    bf16* WGU = (bf16*)(ws + WS_WGU); bf16* WDN = (bf16*)(ws + WS_WDN); bf16* WINS = (bf16*)(ws + WS_WINS); bf16* WINR = (bf16*)(ws + WS_WINR); bf16* WOUT = (bf16*)(ws + WS_WOUT);
    bf16* WMEM = (bf16*)(ws + WS_WMEM); bf16* XMEMB = (bf16*)(ws + WS_XMEMB); float* MEMKV = (float*)(ws + WS_MEMKV); float* X = (float*)(ws + WS_X); bf16* XN = (bf16*)(ws + WS_XN);
    float* GU = (float*)(ws + WS_GU); bf16* H = (bf16*)(ws + WS_H); float* Y = (float*)(ws + WS_Y); float* QKV = (float*)(ws + WS_QKV); float* ORAW = (float*)(ws + WS_ORAW); bf16* OCAT = (bf16*)(ws + WS_OCAT);
    const int CG = 2048;
    for (int i = 0; i < 8; ++i) {
        hipLaunchKernelGGL(k_conv_w, dim3(CG), dim3(256), 0, stream, w_gu + (size_t)i * D * NGU, D, NGU, 0, NGU, WGU + (size_t)i * NGU * D, 0);
        hipLaunchKernelGGL(k_conv_w, dim3(CG), dim3(256), 0, stream, w_dn + (size_t)i * DFF * D, DFF, D, 0, D, WDN + (size_t)i * D * DFF, 0);
    }
    for (int j = 0; j < 2; ++j) {
        hipLaunchKernelGGL(k_conv_w, dim3(CG), dim3(256), 0, stream, swa_w_in + (size_t)j * D * SWA_IN, D, SWA_IN, 0, SWA_IN, WINS + (size_t)j * SWA_IN * D, 0);
        hipLaunchKernelGGL(k_conv_w, dim3(CG), dim3(256), 0, stream, ret_w_in + (size_t)j * D * RET_IN, D, RET_IN, 0, RET_IN, WINR + (size_t)j * RET_IN * D, 0);
        hipLaunchKernelGGL(k_conv_w, dim3(CG), dim3(256), 0, stream, swa_w_out + (size_t)j * D * D, D, D, 0, D, WOUT + (size_t)(2 * j) * D * D, 0);
        hipLaunchKernelGGL(k_conv_w, dim3(CG), dim3(256), 0, stream, ret_w_out + (size_t)j * D * D, D, D, 0, D, WOUT + (size_t)(2 * j + 1) * D * D, 0);
    }
    for (int l = 0; l < 4; ++l) hipLaunchKernelGGL(k_conv_w, dim3(CG), dim3(256), 0, stream, w_mem + (size_t)l * D * 1024, D, 1024, 0, 1024, WMEM, 1024 * l);
    hipLaunchKernelGGL(k_cast, dim3(2048), dim3(256), 0, stream, x_prompt, X, XN, (size_t)MP * D / 4);
    hipLaunchKernelGGL(k_cast, dim3(64), dim3(256), 0, stream, x_sample, X + (size_t)MP * D, XN + (size_t)MP * D, (size_t)SB * D / 4);
    hipLaunchKernelGGL(k_cast, dim3(1024), dim3(256), 0, stream, mem_prompt, (float*)nullptr, XMEMB, (size_t)1024 * D / 4);
    launch_gemm(stream, XMEMB, WMEM, MEMKV, 4096, 1024, 4096, D);
    hipLaunchKernelGGL(k_mem_scatter, dim3(2048), dim3(256), 0, stream, MEMKV, out);
    for (int L = 0; L < DEPTH; ++L) {
        const int j = L / 2;
        for (int s = 0; s < 2; ++s) {
            const int wi = 2 * L + s, lni = 3 * L + (s == 0 ? 0 : 2);
            launch_gemm(stream, XN, WGU + (size_t)wi * NGU * D, GU, NGU, MT, NGU, D);
            hipLaunchKernelGGL(k_silu_mul, dim3(4096), dim3(256), 0, stream, GU, H, MR);
            launch_gemm(stream, H, WDN + (size_t)wi * D * DFF, Y, D, MT, D, DFF);
            hipLaunchKernelGGL(k_ln_res, dim3(2056), dim3(256), 0, stream, X, Y, 0.5f, ln_g + (size_t)lni * D, ln_b + (size_t)lni * D, XN, MR);
            if (s == 1) break;
            const float* MK = out + O_MK + (size_t)L * 1024 * 512; const float* MV = out + O_MV + (size_t)L * 1024 * 512;
            const float* CMK = cache_mem_k + (size_t)L * SB * 256 * 512; const float* CMV = cache_mem_v + (size_t)L * SB * 256 * 512;
            if ((L & 1) == 0) {
                launch_gemm(stream, XN, WINS + (size_t)j * SWA_IN * D, QKV, SWA_IN, MT, SWA_IN, D);
                hipLaunchKernelGGL(k_rope, dim3(4096), dim3(256), 0, stream, QKV, MR);
                const float* CK = cache_swa_k + (size_t)j * SB * 128 * 512; const float* CV = cache_swa_v + (size_t)j * SB * 128 * 512;
                hipLaunchKernelGGL(k_attn_swa_prompt, dim3(4096), dim3(256), 0, stream, QKV, swa_sinks + j * 12, OCAT);
                hipLaunchKernelGGL(k_attn_mem_prompt, dim3(4096), dim3(256), 0, stream, QKV, SWA_IN, 2560, MK, MV, OCAT);
                hipLaunchKernelGGL(k_attn_swa_sample, dim3(96), dim3(256), 0, stream, QKV, CK, CV, swa_sinks + j * 12, OCAT);
                hipLaunchKernelGGL(k_attn_mem_sample, dim3(32), dim3(256), 0, stream, QKV, SWA_IN, 2560, CMK, CMV, OCAT);
                hipLaunchKernelGGL(k_swa_cache_out, dim3(2048), dim3(256), 0, stream, QKV, CK, CV, out, j);
            } else {
                launch_gemm(stream, XN, WINR + (size_t)j * RET_IN * D, QKV, RET_IN, MT, RET_IN, D);
                hipLaunchKernelGGL(k_ret_rot, dim3(4096), dim3(256), 0, stream, QKV, MR);
                hipLaunchKernelGGL(k_ret_seq, dim3(NB * 6), dim3(256), 0, stream, QKV, 0, SEQ, (const float*)nullptr, out + O_RSP + (size_t)j * NB * 6 * 128 * 256, ORAW);
                hipLaunchKernelGGL(k_ret_seq, dim3(SB * 6), dim3(256), 0, stream, QKV, MP, 1, state_ret + (size_t)j * SB * 6 * 128 * 256, out + O_RSS + (size_t)j * SB * 6 * 128 * 256, ORAW);
                hipLaunchKernelGGL(k_headnorm_gate, dim3(4096), dim3(256), 0, stream, ORAW, QKV, OCAT, MR);
                hipLaunchKernelGGL(k_attn_mem_prompt, dim3(4096), dim3(256), 0, stream, QKV, RET_IN, 4608, MK, MV, OCAT);
                hipLaunchKernelGGL(k_attn_mem_sample, dim3(32), dim3(256), 0, stream, QKV, RET_IN, 4608, CMK, CMV, OCAT);
            }
            launch_gemm(stream, OCAT, WOUT + (size_t)L * D * D, Y, D, MT, D, D);
            hipLaunchKernelGGL(k_ln_res, dim3(2056), dim3(256), 0, stream, X, Y, 1.0f, ln_g + (size_t)(3 * L + 1) * D, ln_b + (size_t)(3 * L + 1) * D, XN, MR);
        }
    }
    hipMemcpyAsync(out + O_YP, X, (size_t)MR * D * 4, hipMemcpyDeviceToDevice, stream);
}
```

```cpp
#include <hip/hip_runtime.h>
#include <cstdio>
#include <cstdint>
namespace pg8 {
#define PG8_LAS __attribute__((address_space(3)))
typedef unsigned short bf16_t;
typedef short bf16x8 __attribute__((ext_vector_type(8)));
typedef float f32x4 __attribute__((ext_vector_type(4)));
typedef unsigned u32x4 __attribute__((ext_vector_type(4)));
constexpr int BM = 256, BK = 64, HALF = 128, HTB = HALF * BK * 2  , STAGE_BYTES = 8 * HTB, NXCD = 8, WGM = 8;

__host__ __device__ __forceinline__ int lds_byte(int r, int c) { const int st = (r >> 4) * 2 + (c >> 5), rr = r & 15, cc = c & 31, ob = rr * 64 + cc * 2; return st * 1024 + (ob ^ (((ob >> 9) & 1) << 5)); }
__host__ __device__ __forceinline__ void stage_rc(int b, int& R, int& C) { const int st = b / 1024, sb = b % 1024, swz = sb ^ (((sb >> 9) & 1) << 5); R = (st >> 1) * 16 + swz / 64; C = (st & 1) * 32 + (swz % 64) / 2; }
__host__ __device__ __forceinline__ int perm32(int rho) { const int n = rho >> 4, i = rho & 15; return 8 * (i >> 2) + 4 * n + (i & 3); }

struct Unit { int pm, pn; };
struct Gemm { const bf16_t* A; const bf16_t* Bt; int M, N, K; };

struct StaticOrder {
    int nM, nN, nwg, G, c;
    __host__ __device__ void init(int M, int N, int G_, int c_) { nM = M / BM; nN = N / BM; nwg = nM * nN; G = G_; c = c_; }
    __host__ __device__ bool next(int i, Unit& u) const {
        const long L = (long)i * G + c; if (L >= nwg) return false;
        int wgid = (int)L; { const int q = nwg / NXCD, r = nwg % NXCD, xcd = wgid % NXCD, off = wgid / NXCD; wgid = (xcd < r ? xcd * (q + 1) : r * (q + 1) + (xcd - r) * q) + off; }
        const int nig = WGM * nN, gid = wgid / nig, fm = gid * WGM, gsz = (nM - fm) < WGM ? (nM - fm) : WGM;
        u.pm = fm + ((wgid % nig) % gsz); u.pn = (wgid % nig) / gsz; return true;
    }
    __device__ __forceinline__ void a_ready(const Unit&) const {}
    __device__ __forceinline__ void done(const Unit&) const {}
};

__device__ __forceinline__ unsigned cvt_pk_bf16(float lo, float hi) { unsigned r; asm volatile("v_cvt_pk_bf16_f32 %0, %1, %2" : "=v"(r) : "v"(lo), "v"(hi)); return r; }
typedef float f32x2 __attribute__((ext_vector_type(2)));

template <class Epi, class Sched, bool ALIGN_EPI = false, bool SP2 = false>
__device__ __forceinline__ void gemm_phase(PG8_LAS unsigned char* lds, const Gemm g, const Sched& S, const Epi& E) {
    int tid_ = threadIdx.x; asm volatile("" : "+v"(tid_)); const int tid = tid_, wid = __builtin_amdgcn_readfirstlane(tid >> 6), lane = tid & 63, wr = wid >> 2, wc = wid & 3, fr = lane & 15, fq = lane >> 4;
    const int K = g.K, nt = K / BK;
    unsigned voffA[2], voffB[2];
#pragma unroll
    for (int i = 0; i < 2; ++i) { int R, C; stage_rc(tid * 16 + i * 8192, R, C); const int Rb = Epi::PERM ? ((R & ~31) + perm32(R & 31)) : R;
        voffA[i] = (unsigned)(R * K + C) * 2u; voffB[i] = (unsigned)(Rb * K + C) * 2u; }
    const size_t kstep = (size_t)(BK * 2);
    const size_t hstep = (size_t)HALF * K * 2;
    const size_t tstep = 2 * hstep;
    const unsigned ldsw = (unsigned)wid * 1024u;
    const int aoff = lds_byte(wr * 64 + fr, fq * 8), boff = lds_byte(wc * 32 + fr, fq * 8);
#define PG8_SA(b, h) (((b) * 2 + (h)) * HTB)
#define PG8_SB(b, h) ((4 + (b) * 2 + (h)) * HTB)
#define PG8_STAGE(bufoff, gbase, voff) do { _Pragma("unroll") for (int _i = 0; _i < 2; ++_i) \
        __builtin_amdgcn_global_load_lds((const unsigned*)((const char*)(gbase) + (voff)[_i]), (PG8_LAS unsigned*)(lds + (bufoff) + ldsw + _i * 8192), 16, 0, 0); } while (0)
#define PG8_LDA(dst, b, h) do { _Pragma("unroll") for (int m = 0; m < 4; ++m) _Pragma("unroll") for (int k = 0; k < 2; ++k) dst[m][k] = *(const PG8_LAS bf16x8*)(lds + PG8_SA(b, h) + aoff + m * 2048 + k * 1024); } while (0)
#define PG8_LDB(dst, b, h) do { _Pragma("unroll") for (int n = 0; n < 2; ++n) _Pragma("unroll") for (int k = 0; k < 2; ++k) dst[n][k] = *(const PG8_LAS bf16x8*)(lds + PG8_SB(b, h) + boff + n * 2048 + k * 1024); } while (0)
#define PG8_MMA(ai, bj, At, Bt) do { __builtin_amdgcn_s_setprio(1); _Pragma("unroll") for (int m = 0; m < 4; ++m) _Pragma("unroll") for (int n = 0; n < 2; ++n) _Pragma("unroll") for (int k = 0; k < 2; ++k) \
        acc[ai][bj][m][n] = __builtin_amdgcn_mfma_f32_16x16x32_bf16(Bt[n][k], At[m][k], acc[ai][bj][m][n], 0, 0, 0); __builtin_amdgcn_s_setprio(0); } while (0)
#define PG8_WAIT_V(n) asm volatile("s_waitcnt vmcnt(" #n ")" ::: "memory")
#define PG8_WAIT_L(n) asm volatile("s_waitcnt lgkmcnt(" #n ")" ::: "memory")
#define PG8_BAR __builtin_amdgcn_s_barrier()
#define PG8_SCHED __builtin_amdgcn_sched_barrier(0)
    Unit cur, nxt; int ui = 0;
    if (!S.next(0, cur)) return;
    f32x4 acc[2][2][4][2];
#pragma unroll
    for (int a = 0; a < 2; ++a)
#pragma unroll
        for (int b = 0; b < 2; ++b)
#pragma unroll
            for (int m = 0; m < 4; ++m)
#pragma unroll
                for (int n = 0; n < 2; ++n) acc[a][b][m][n] = (f32x4){0.f, 0.f, 0.f, 0.f};
    bf16x8 At[4][2], B0[2][2], B1[2][2];
    const char* cA = (const char*)g.A + (size_t)cur.pm * tstep; const char* cB = (const char*)g.Bt + (size_t)cur.pn * tstep;
    S.a_ready(cur);
    if constexpr (SP2) {
        PG8_STAGE(PG8_SB(0, 0), cB, voffB); PG8_STAGE(PG8_SB(0, 1), cB + hstep, voffB); PG8_STAGE(PG8_SA(0, 0), cA, voffA); PG8_STAGE(PG8_SA(0, 1), cA + hstep, voffA);
        if (wr == 1) PG8_BAR;
        PG8_WAIT_V(2); PG8_BAR;
        PG8_STAGE(PG8_SB(1, 0), cB + kstep, voffB); PG8_STAGE(PG8_SA(1, 0), cA + kstep, voffA); PG8_STAGE(PG8_SB(1, 1), cB + hstep + kstep, voffB);
        PG8_WAIT_V(6); PG8_BAR;
    } else {
        PG8_STAGE(PG8_SB(0, 0), cB, voffB); PG8_STAGE(PG8_SA(0, 0), cA, voffA); PG8_STAGE(PG8_SB(0, 1), cB + hstep, voffB); PG8_STAGE(PG8_SA(0, 1), cA + hstep, voffA);
        if (wr == 1) PG8_BAR;
        PG8_WAIT_V(4); PG8_BAR;
        PG8_STAGE(PG8_SB(1, 0), cB + kstep, voffB); PG8_STAGE(PG8_SA(1, 0), cA + kstep, voffA); PG8_STAGE(PG8_SB(1, 1), cB + hstep + kstep, voffB);
        PG8_WAIT_V(6); PG8_BAR;
    }
    for (;;) {
        const bool has_next = S.next(ui + 1, nxt);
        const char* nA = has_next ? (const char*)g.A + (size_t)nxt.pm * tstep : cA; const char* nB = has_next ? (const char*)g.Bt + (size_t)nxt.pn * tstep : cB;
        for (int t = 0; t < nt; t += 2) {
            const bool last = (t == nt - 2);
            const char* a1 = cA + (size_t)(t + 1) * kstep;
            const char* a2 = last ? nA : cA + (size_t)(t + 2) * kstep; const char* b2 = last ? nB : cB + (size_t)(t + 2) * kstep;
            const char* a3 = a2 + kstep; const char* b3 = b2 + kstep;
            if (last && has_next) S.a_ready(nxt);
            if constexpr (SP2) {
            PG8_LDB(B0, 0, 0); PG8_LDB(B1, 0, 1); PG8_SCHED; PG8_LDA(At, 0, 0); PG8_STAGE(PG8_SA(1, 1), a1 + hstep, voffA);
            PG8_WAIT_V(8); PG8_WAIT_L(0); PG8_BAR; PG8_MMA(0, 0, At, B0); PG8_MMA(0, 1, At, B1); PG8_BAR; PG8_SCHED;
            PG8_LDA(At, 0, 1); PG8_STAGE(PG8_SB(0, 0), b2, voffB); PG8_STAGE(PG8_SB(0, 1), b2 + hstep, voffB); PG8_STAGE(PG8_SA(0, 0), a2, voffA);
            PG8_WAIT_V(8); PG8_WAIT_L(0); PG8_BAR; PG8_MMA(1, 0, At, B0); PG8_MMA(1, 1, At, B1); PG8_BAR; PG8_SCHED;
            PG8_LDB(B0, 1, 0); PG8_LDB(B1, 1, 1); PG8_SCHED; PG8_LDA(At, 1, 0); PG8_STAGE(PG8_SA(0, 1), a2 + hstep, voffA);
            PG8_WAIT_V(8); PG8_WAIT_L(0); PG8_BAR; PG8_MMA(0, 0, At, B0); PG8_MMA(0, 1, At, B1); PG8_BAR; PG8_SCHED;
            PG8_LDA(At, 1, 1); PG8_STAGE(PG8_SB(1, 0), b3, voffB); PG8_STAGE(PG8_SB(1, 1), b3 + hstep, voffB); PG8_STAGE(PG8_SA(1, 0), a3, voffA);
            PG8_WAIT_V(8); PG8_WAIT_L(0); PG8_BAR; PG8_MMA(1, 0, At, B0); PG8_MMA(1, 1, At, B1); PG8_BAR; PG8_SCHED;
            } else {
            PG8_LDB(B0, 0, 0); PG8_SCHED; PG8_LDA(At, 0, 0); PG8_STAGE(PG8_SA(1, 1), a1 + hstep, voffA);
            PG8_WAIT_L(8); PG8_BAR; PG8_WAIT_L(0); PG8_MMA(0, 0, At, B0); PG8_BAR; PG8_SCHED;
            PG8_LDB(B1, 0, 1); PG8_STAGE(PG8_SB(0, 0), b2, voffB);
            PG8_BAR; PG8_WAIT_L(0); PG8_MMA(0, 1, At, B1); PG8_BAR;
            PG8_LDA(At, 0, 1); PG8_STAGE(PG8_SA(0, 0), a2, voffA);
            PG8_BAR; PG8_WAIT_L(0); PG8_MMA(1, 0, At, B0); PG8_BAR; PG8_SCHED;
            PG8_STAGE(PG8_SB(0, 1), b2 + hstep, voffB);
            PG8_WAIT_V(6); PG8_BAR; PG8_MMA(1, 1, At, B1); PG8_BAR;
            PG8_LDB(B0, 1, 0); PG8_SCHED; PG8_LDA(At, 1, 0); PG8_STAGE(PG8_SA(0, 1), a2 + hstep, voffA);
            PG8_WAIT_L(8); PG8_BAR; PG8_WAIT_L(0); PG8_MMA(0, 0, At, B0); PG8_BAR; PG8_SCHED;
            PG8_LDB(B1, 1, 1); PG8_STAGE(PG8_SB(1, 0), b3, voffB);
            PG8_BAR; PG8_WAIT_L(0); PG8_MMA(0, 1, At, B1); PG8_BAR;
            PG8_LDA(At, 1, 1); PG8_STAGE(PG8_SA(1, 0), a3, voffA);
            PG8_BAR; PG8_WAIT_L(0); PG8_MMA(1, 0, At, B0); PG8_BAR; PG8_SCHED;
            PG8_STAGE(PG8_SB(1, 1), b3 + hstep, voffB);
            PG8_WAIT_V(6); PG8_BAR; PG8_MMA(1, 1, At, B1); PG8_BAR;
            }
        }
        if constexpr (ALIGN_EPI) { if (wr == 0) PG8_BAR; }
        if constexpr (!Epi::AFTER_DRAIN) { E(acc, cur, wr, wc, fr, fq); S.done(cur); }
        if (!has_next) break;
#pragma unroll
        for (int a = 0; a < 2; ++a)
#pragma unroll
            for (int b = 0; b < 2; ++b)
#pragma unroll
                for (int m = 0; m < 4; ++m)
#pragma unroll
                    for (int n = 0; n < 2; ++n) acc[a][b][m][n] = (f32x4){0.f, 0.f, 0.f, 0.f};
        cur = nxt; cA = nA; cB = nB; ++ui;
        if constexpr (ALIGN_EPI) { if (wr == 1) PG8_BAR; }
    }
    PG8_WAIT_V(0);
    if constexpr (!ALIGN_EPI) { if (wr == 0) PG8_BAR; }
    PG8_BAR;
    if constexpr (Epi::AFTER_DRAIN) { E.fused(acc, cur, wr, wc, fr, fq, lds, wid, lane); S.done(cur); }
#undef PG8_SA
#undef PG8_SB
#undef PG8_STAGE
#undef PG8_LDA
#undef PG8_LDB
#undef PG8_MMA
#undef PG8_WAIT_V
#undef PG8_WAIT_L
#undef PG8_BAR
#undef PG8_SCHED
}
}

#define GAS __attribute__((address_space(1)))
#define LAS __attribute__((address_space(3)))
typedef unsigned short bf16;
typedef unsigned v4u __attribute__((ext_vector_type(4)));
typedef float f32x4 __attribute__((ext_vector_type(4)));
typedef short bf16x8 __attribute__((ext_vector_type(8)));
typedef GAS unsigned gu32;
typedef GAS unsigned long long gu64;
#define RLX_AGENT __ATOMIC_RELAXED, __HIP_MEMORY_SCOPE_AGENT
#define LDS_WAIT() asm volatile("s_waitcnt lgkmcnt(0)" ::: "memory")
#define VM_WAIT() asm volatile("s_waitcnt vmcnt(0)" ::: "memory")
__device__ __forceinline__ unsigned long long rt() { return __builtin_amdgcn_s_memrealtime(); }
__device__ __forceinline__ unsigned f2bf(float f) { unsigned u = __builtin_bit_cast(unsigned, f); return (u + 0x7fffu + ((u >> 16) & 1u)) >> 16; }
__device__ __forceinline__ unsigned pk2(float lo, float hi) { return f2bf(lo) | (f2bf(hi) << 16); }

#define XB_TMO      128
#define XB_XCNT(j)  (256  + 64 * (j))
#define XB_XSUB(j)  (1280 + 64 * (j))
#define XB_XGEN(j)  (2304 + 64 * (j))
#define XB_TOP      3328
#define XB_TOPGEN   3392
#define XCD_BAR_WORDS 3456
#define XB_SPIN_CAP (1u << 18)

__device__ __forceinline__ unsigned xb_ld(unsigned* p)              { return __hip_atomic_load(p, __ATOMIC_RELAXED, __HIP_MEMORY_SCOPE_AGENT); }
__device__ __forceinline__ unsigned xb_add(unsigned* p, unsigned v) { return __hip_atomic_fetch_add(p, v, __ATOMIC_RELAXED, __HIP_MEMORY_SCOPE_AGENT); }
__device__ __forceinline__ unsigned xb_xcc_id() { return (unsigned)__builtin_amdgcn_s_getreg((3 << 11) | 20) & 0xFu; }
#define XB_SPIN(cond, bar) do { unsigned _sp = 0; while (cond) { __builtin_amdgcn_s_sleep(1); \
    if ((++_sp & 255u) == 0u) { if (xb_ld(&(bar)[XB_TMO])) break; if (_sp > XB_SPIN_CAP) { atomicAdd(&(bar)[XB_TMO], 1u); break; } } } } while (0)

struct XcdBarrier {
    unsigned* bar; unsigned x;
    volatile LAS unsigned* st;
};

__device__ __forceinline__ XcdBarrier xcd_barrier_post(unsigned* bar, volatile LAS unsigned* st) {
    XcdBarrier b; b.bar = bar; b.x = xb_xcc_id(); b.st = st;
    if (threadIdx.x == 0) (void)xb_add(&bar[XB_XCNT(b.x)], 1u);
    return b;
}
__device__ __forceinline__ void xcd_barrier_complete(unsigned* bar, unsigned x, unsigned& nloc, unsigned& nx) {
    const unsigned G = gridDim.x * gridDim.y * gridDim.z;
    unsigned sum, cnt, mine, sp = 0u;
    for (;;) {
        sum = 0u; cnt = 0u; mine = 0u;
#pragma unroll
        for (unsigned j = 0; j < 16; ++j) { const unsigned c = xb_ld(&bar[XB_XCNT(j)]); sum += c; cnt += (c > 0u) ? 1u : 0u; mine = (j == x) ? c : mine; }
        if (sum == G) break;
        __builtin_amdgcn_s_sleep(1);
        if ((++sp & 255u) == 0u) { if (xb_ld(&bar[XB_TMO])) break; if (sp > XB_SPIN_CAP) { atomicAdd(&bar[XB_TMO], 1u); break; } }
    }
    nloc = mine > 0u ? mine : 1u; nx = cnt > 0u ? cnt : 1u;
}

__device__ __forceinline__ void xcd_barrier(const XcdBarrier& b) {
    asm volatile("s_waitcnt vmcnt(0)" ::: "memory");
    __syncthreads();
    if (threadIdx.x == 0) {
        unsigned* bar = b.bar;
        __builtin_amdgcn_s_waitcnt(0);
        unsigned nloc = b.st[0], nx = b.st[1];
        if (nloc == 0u) { xcd_barrier_complete(bar, b.x, nloc, nx); b.st[0] = nloc; b.st[1] = nx; }
        const unsigned old = xb_add(&bar[XB_XSUB(b.x)], 1u);
        const unsigned gen = old / nloc;
        if (old + 1u == (gen + 1u) * nloc) {
            __builtin_amdgcn_fence(__ATOMIC_RELEASE, "agent");
            asm volatile("s_waitcnt vmcnt(0)" ::: "memory");
            const unsigned og = xb_add(&bar[XB_TOP], 1u);
            const unsigned tg = og / nx;
            if (og + 1u == (tg + 1u) * nx) xb_add(&bar[XB_TOPGEN], 1u);
            else XB_SPIN(xb_ld(&bar[XB_TOPGEN]) == tg, bar);
            __builtin_amdgcn_fence(__ATOMIC_ACQUIRE, "agent");
            xb_add(&bar[XB_XGEN(b.x)], 1u);
            asm volatile("s_waitcnt vmcnt(0)" ::: "memory");
        } else {
            XB_SPIN(xb_ld(&bar[XB_XGEN(b.x)]) == gen, bar);
            __builtin_amdgcn_fence(__ATOMIC_ACQUIRE, "agent");
            asm volatile("s_waitcnt vmcnt(0)" ::: "memory");
        }
    }
    __syncthreads();
}


constexpr int D = 2048, DFF = 5632, NGU = 2 * DFF, NB = 4, SEQ = 2048, MP = NB * SEQ, SB = 32, MR = MP + SB, MT = 8448;
constexpr int DEPTH = 4, PAST = 16384;
constexpr int SWA_IN = 3072, RET_IN = 5120;
constexpr float LN_EPS = 1e-5f, HN_EPS = 1e-6f;
constexpr float ALPHA = 1.6817928305074292f;
constexpr float QSCALE = 0.08838834764831845f;
constexpr int NWAVES = 8, NTHR = 512;

__device__ __forceinline__ float wave_sum(float v) {
#pragma unroll
    for (int o = 1; o < 64; o <<= 1) v += __shfl_xor(v, o);
    return v;
}
__device__ __forceinline__ float silu_f(float x) { return x * __builtin_amdgcn_rcpf(1.0f + __expf(-x)); }

constexpr size_t WS_CTL = 0, CTL_BYTES = 2u << 20;
constexpr int CW_BAR = 4096, CW_Q = 64;
constexpr size_t CTL_ST = 65536, ST_BYTES = (size_t)MP * 16;
constexpr float ST_SCALE = 16777216.0f, ST_INV = 1.0f / 16777216.0f;
__device__ __forceinline__ float ll2f(long long v) { return (float)(int)(v >> 32) * 4294967296.0f + (float)(unsigned)v; }
static_assert(CTL_ST + 13 * ST_BYTES <= CTL_BYTES, "ctl");
constexpr size_t SZ_WGU = (size_t)NGU * D * 2, SZ_WDN = (size_t)D * DFF * 2, SZ_WINS = (size_t)SWA_IN * D * 2, SZ_WINR = (size_t)RET_IN * D * 2, SZ_WOUT = (size_t)D * D * 2;
constexpr size_t WS_WGU = WS_CTL + CTL_BYTES;
constexpr size_t WS_WDN = WS_WGU + 8 * SZ_WGU;
constexpr size_t WS_WINS = WS_WDN + 8 * SZ_WDN;
constexpr size_t WS_WINR = WS_WINS + 2 * SZ_WINS;
constexpr size_t WS_WOUT = WS_WINR + 2 * SZ_WINR;
constexpr size_t WS_WMEM = WS_WOUT + 4 * SZ_WOUT;
constexpr size_t WS_C1GU = WS_WMEM + (size_t)4096 * D * 2;
constexpr size_t WS_C1INS = WS_C1GU + (size_t)2 * 8 * NGU * 4;
constexpr size_t WS_C1INR = WS_C1INS + (size_t)2 * 2 * SWA_IN * 4;
constexpr size_t WS_ONES = WS_C1INR + (size_t)2 * 2 * RET_IN * 4;
constexpr size_t WS_ROPE = WS_ONES + (size_t)2 * D * 4;
constexpr size_t WS_RETCS = WS_ROPE + (size_t)SEQ * 16 * 8;
constexpr size_t WS_XMEMB = WS_RETCS + (size_t)SEQ * 64 * 8;
constexpr size_t WS_Z = WS_XMEMB + (size_t)1024 * D * 2;
constexpr size_t SZ_Z = (size_t)MT * D * 2;
constexpr size_t WS_H = WS_Z + 2 * SZ_Z;
constexpr size_t WS_QKV = WS_H + (size_t)MT * DFF * 2;
constexpr size_t WS_ORAW = WS_QKV + (size_t)MT * RET_IN * 4;
constexpr size_t WS_OCAT = WS_ORAW + (size_t)MT * 1536 * 4;
constexpr size_t WS_QKVB = WS_OCAT + (size_t)MT * D * 2;
constexpr size_t WS_DST = WS_QKVB + (size_t)MT * RET_IN * 2;
constexpr size_t WS_SC = WS_DST + (size_t)NB * 6 * 16 * 32768 * 4;
constexpr size_t WS_MEMKB = WS_SC + (size_t)NB * 6 * 16 * 32768 * 2;
constexpr size_t WS_END = WS_MEMKB + (size_t)4 * 1024 * 1024 * 2;

constexpr size_t O_YP = 0, O_YS = O_YP + (size_t)MP * D, O_SKP = O_YS + (size_t)SB * D, O_SVP = O_SKP + 2 * 4 * 128 * 512, O_SKS = O_SVP + 2 * 4 * 128 * 512,
                 O_SVS = O_SKS + (size_t)2 * 32 * 128 * 512, O_RSP = O_SVS + (size_t)2 * 32 * 128 * 512, O_RSS = O_RSP + (size_t)2 * 4 * 6 * 128 * 256,
                 O_MK = O_RSS + (size_t)2 * 32 * 6 * 128 * 256, O_MV = O_MK + (size_t)4 * 4 * 256 * 512, O_END = O_MV + (size_t)4 * 4 * 256 * 512;

constexpr int RING_OFF = 0, RING_BYTES = 131072;
constexpr int LDSCTL_OFF = 147456, MISC_OFF = LDSCTL_OFF + 320;
constexpr int SSTAT_OFF = LDSCTL_OFF + 512;
constexpr int LDS_BYTES = LDSCTL_OFF + 1024;

struct Args { const float* in[18]; float* out; unsigned char* ws; };

struct Frame {
    LAS unsigned char* lds;
    int tid, lane, wave, G, bid;
    size_t gtid, ngt; int gw, ngw;
};
__device__ __forceinline__ bf16* zbuf(unsigned char* ws, int v) { return (bf16*)(ws + WS_Z + (size_t)(v & 1) * SZ_Z); }
__device__ __forceinline__ long long* stbuf(unsigned char* ws, int v) { return (long long*)(ws + WS_CTL + CTL_ST + (size_t)v * ST_BYTES); }
__device__ __forceinline__ const float* lngain(const Args& a, int v) { return v ? a.in[8] + (size_t)(v - 1) * D : (const float*)(a.ws + WS_ONES); }
__device__ __forceinline__ const float* lnbias(const Args& a, int v) { return v ? a.in[9] + (size_t)(v - 1) * D : (const float*)(a.ws + WS_ONES) + D; }
__device__ __forceinline__ float bf2f(unsigned h) { return __builtin_bit_cast(float, h << 16); }
__device__ __forceinline__ unsigned f2bfh(float f) { unsigned u = __builtin_bit_cast(unsigned, f); u += 0x1ffffu + ((u >> 18) & 1u); return (u >> 18) << 2; }
__device__ __forceinline__ unsigned pkh(float lo, float hi) { return f2bfh(lo) | (f2bfh(hi) << 16); }

typedef float f32x2_t __attribute__((ext_vector_type(2)));
typedef long long i64x2_t __attribute__((ext_vector_type(2)));
__device__ __forceinline__ void row_stats(const long long* st, int row, float& mu, float& rstd) {
    const i64x2_t s = *(const i64x2_t*)(st + 2 * (size_t)row); mu = ll2f(s.x) * (ST_INV / D); const float var = ll2f(s.y) * (ST_INV / D) - mu * mu; rstd = __builtin_amdgcn_rsqf(fmaxf(var, 0.f) + LN_EPS);
}
struct EpiGU {
    static constexpr bool PERM = true, AFTER_DRAIN = false;
    bf16* H; const long long* st; const float* c1; const float* c2;
    __device__ __forceinline__ void operator()(const f32x4 (&acc)[2][2][4][2], const pg8::Unit& u, int wr, int wc, int fr, int fq) const {
        const int row0 = u.pm * 256 + wr * 64 + fr, s0 = u.pn * 256 + wc * 32 + 8 * fq, hc0 = u.pn * 128 + wc * 32 + 8 * fq;
        f32x4 k1[2][2], k2[2][2];
#pragma unroll
        for (int bj = 0; bj < 2; ++bj)
#pragma unroll
            for (int n = 0; n < 2; ++n) { k1[bj][n] = *(const f32x4*)(c1 + s0 + 128 * bj + 4 * n); k2[bj][n] = *(const f32x4*)(c2 + s0 + 128 * bj + 4 * n); }
#pragma unroll
        for (int ai = 0; ai < 2; ++ai)
#pragma unroll
            for (int m = 0; m < 4; ++m) { const int row = row0 + ai * 128 + m * 16; float mu, rs; row_stats(st, row, mu, rs);
                float h[8];
#pragma unroll
                for (int n = 0; n < 2; ++n)
#pragma unroll
                    for (int e = 0; e < 4; ++e) { const float g = rs * (acc[ai][0][m][n][e] - mu * k1[0][n][e]) + k2[0][n][e], uu = rs * (acc[ai][1][m][n][e] - mu * k1[1][n][e]) + k2[1][n][e]; h[4 * n + e] = silu_f(g) * uu; }
                v4u w; w.x = pkh(h[0], h[1]); w.y = pkh(h[2], h[3]); w.z = pkh(h[4], h[5]); w.w = pkh(h[6], h[7]);
                *(v4u*)(H + (size_t)row * DFF + hc0) = w; }
    }
};
struct EpiRes {
    static constexpr bool PERM = true, AFTER_DRAIN = false;
    const bf16* Zo; bf16* Zn; const long long* sto; long long* stn; const float* g; const float* b; float s; int pad;
    __device__ __forceinline__ void operator()(const f32x4 (&acc)[2][2][4][2], const pg8::Unit& u, int wr, int wc, int fr, int fq) const {
        const int row0 = u.pm * 256 + wr * 64 + fr, c0 = u.pn * 256 + wc * 32 + 8 * fq;
#pragma unroll
        for (int bj = 0; bj < 2; ++bj) {
            const int cb = c0 + 128 * bj;
            const f32x4 ga0 = *(const f32x4*)(g + cb) * ALPHA, ga1 = *(const f32x4*)(g + cb + 4) * ALPHA, ba0 = *(const f32x4*)(b + cb) * ALPHA, ba1 = *(const f32x4*)(b + cb + 4) * ALPHA;
#pragma unroll
            for (int ai = 0; ai < 2; ++ai) {
                v4u zo4[4]; i64x2_t st4[4];
#pragma unroll
                for (int m = 0; m < 4; ++m) { const int row = row0 + ai * 128 + m * 16; zo4[m] = *(const v4u*)(Zo + (size_t)row * D + cb); st4[m] = *(const i64x2_t*)(sto + 2 * (size_t)row); }
#pragma unroll
                for (int m = 0; m < 4; ++m) { const int row = row0 + ai * 128 + m * 16;
                    const float mu = ll2f(st4[m].x) * (ST_INV / D), var = ll2f(st4[m].y) * (ST_INV / D) - mu * mu, rs = __builtin_amdgcn_rsqf(fmaxf(var, 0.f) + LN_EPS);
                    const v4u zo = zo4[m]; float z[8];
#pragma unroll
                    for (int n = 0; n < 2; ++n)
#pragma unroll
                        for (int e = 0; e < 4; ++e) { const unsigned wd = zo[2 * n + (e >> 1)]; const float zf = bf2f((e & 1) ? (wd >> 16) : (wd & 0xffffu));
                            z[4 * n + e] = (zf - mu) * rs * (n ? ga1[e] : ga0[e]) + (n ? ba1[e] : ba0[e]) + s * acc[ai][bj][m][n][e]; }
                    v4u w; w.x = pk2(z[0], z[1]); w.y = pk2(z[2], z[3]); w.z = pk2(z[4], z[5]); w.w = pk2(z[6], z[7]);
                    *(v4u*)(Zn + (size_t)row * D + cb) = w;
                    float sum = 0.f, sq = 0.f;
#pragma unroll
                    for (int q = 0; q < 4; ++q) { const float lo = bf2f(w[q] & 0xffffu), hi = bf2f(w[q] >> 16); sum += lo + hi; sq += lo * lo + hi * hi; }
                    sum += __shfl_xor(sum, 16); sum += __shfl_xor(sum, 32); sq += __shfl_xor(sq, 16); sq += __shfl_xor(sq, 32);
                    if (fq < 2 && pad == 0) __hip_atomic_fetch_add((unsigned long long*)(stn + 2 * (size_t)row + fq), (unsigned long long)__float2ll_rn((fq ? sq : sum) * ST_SCALE), __ATOMIC_RELAXED, __HIP_MEMORY_SCOPE_AGENT); }
                asm volatile("" ::: "memory");
            }
        }
    }
};
template <int KIND> struct EpiIn {
    static constexpr bool PERM = true, AFTER_DRAIN = false;
    bf16* QB; const long long* st; const float* c1; const float* c2; const f32x4* rope; const f32x4* retcs; float* out; int jl, pad;
    __device__ __forceinline__ void operator()(const f32x4 (&acc)[2][2][4][2], const pg8::Unit& u, int wr, int wc, int fr, int fq) const {
        constexpr int N = KIND == 0 ? SWA_IN : RET_IN;
        constexpr int NT = KIND == 0 ? 4 : 2;
        const int row0 = u.pm * 256 + wr * 64 + fr, c0 = u.pn * 256 + wc * 32 + 8 * fq, pn = u.pn;
        const bool rot = KIND == 0 ? (pn < 8 && wc == 0) : (pn < 6);
#pragma unroll
        for (int bj = 0; bj < 2; ++bj) {
            const int cb = c0 + 128 * bj;
            const f32x4 k10 = *(const f32x4*)(c1 + cb), k11 = *(const f32x4*)(c1 + cb + 4), k20 = *(const f32x4*)(c2 + cb), k21 = *(const f32x4*)(c2 + cb + 4);
#pragma unroll
            for (int ai = 0; ai < 2; ++ai) {
                i64x2_t st4[4];
#pragma unroll
                for (int m = 0; m < 4; ++m) st4[m] = *(const i64x2_t*)(st + 2 * (size_t)(row0 + ai * 128 + m * 16));
#pragma unroll
                for (int mp = 0; mp < 2; ++mp) {
                    f32x4 tb[2][NT];
                    if (rot) {
#pragma unroll
                        for (int q2 = 0; q2 < 2; ++q2) { const int pos = (row0 + ai * 128 + (2 * mp + q2) * 16) & (SEQ - 1);
                            const f32x4* cs = KIND == 0 ? rope + (size_t)pos * 8 + 4 * (fq & 1) : retcs + (size_t)pos * 32 + ((cb & 127) >> 2);
#pragma unroll
                            for (int q = 0; q < NT; ++q) tb[q2][q] = cs[q]; }
                    }
#pragma unroll
                    for (int q2 = 0; q2 < 2; ++q2) { const int m = 2 * mp + q2, row = row0 + ai * 128 + m * 16, pos = row & (SEQ - 1);
                        const float mu = ll2f(st4[m].x) * (ST_INV / D), var = ll2f(st4[m].y) * (ST_INV / D) - mu * mu, rs = __builtin_amdgcn_rsqf(fmaxf(var, 0.f) + LN_EPS);
                        float v[8];
#pragma unroll
                        for (int e = 0; e < 4; ++e) { v[e] = rs * (acc[ai][bj][m][0][e] - mu * k10[e]) + k20[e]; v[4 + e] = rs * (acc[ai][bj][m][1][e] - mu * k11[e]) + k21[e]; }
                        if (KIND == 0) {
                            if (rot) {
#pragma unroll
                                for (int q = 0; q < 4; ++q) { const f32x4 t = tb[q2][q];
#pragma unroll
                                    for (int hh = 0; hh < 2; ++hh) { const int jx = 2 * q + hh; const float c = hh ? t[2] : t[0], sn = hh ? t[3] : t[1]; const float o = __shfl_xor(v[jx], 32);
                                        v[jx] = (fq < 2) ? v[jx] * c - o * sn : v[jx] * c + o * sn; } }
                            }
                            if (pn >= 6 && pn < 10 && pos >= SEQ - 128) {
                                float* o = out + (pn < 8 ? O_SKP : O_SVP) + (((size_t)jl * NB + (row >> 11)) * 128 + (pos - (SEQ - 128))) * 512 + (cb - (pn < 8 ? 1536 : 2048));
                                *(f32x4*)o = (f32x4){v[0], v[1], v[2], v[3]}; *(f32x4*)(o + 4) = (f32x4){v[4], v[5], v[6], v[7]}; }
                        } else {
                            if (rot) {
                                const float sc = pn < 3 ? 1.0f : QSCALE;
#pragma unroll
                                for (int q = 0; q < 2; ++q) { const f32x4 t = tb[q2][q];
#pragma unroll
                                    for (int hh = 0; hh < 2; ++hh) { const int jx = 4 * q + 2 * hh; const float c = hh ? t[2] : t[0], sn = hh ? t[3] : t[1]; const float x1 = v[jx], x2 = v[jx + 1];
                                        v[jx] = (x1 * c - x2 * sn) * sc; v[jx + 1] = (x2 * c + x1 * sn) * sc; } }
                            }
                        }
                        v4u w; w.x = pk2(v[0], v[1]); w.y = pk2(v[2], v[3]); w.z = pk2(v[4], v[5]); w.w = pk2(v[6], v[7]);
                        *(v4u*)(QB + (size_t)row * N + cb) = w; }
                }
                asm volatile("" ::: "memory");
            }
        }
    }
};
struct EpiMem {
    static constexpr bool PERM = true, AFTER_DRAIN = false;
    float* out; bf16* MKB;
    __device__ __forceinline__ void operator()(const f32x4 (&acc)[2][2][4][2], const pg8::Unit& u, int wr, int wc, int fr, int fq) const {
        const int row0 = u.pm * 256 + wr * 64 + fr, l = u.pn >> 2, e0 = (u.pn & 3) * 256 + wc * 32 + 8 * fq;
#pragma unroll
        for (int ai = 0; ai < 2; ++ai)
#pragma unroll
            for (int m = 0; m < 4; ++m) { const int row = row0 + ai * 128 + m * 16;
#pragma unroll
                for (int bj = 0; bj < 2; ++bj) { const int e = e0 + 128 * bj; const f32x4 a0 = acc[ai][bj][m][0], a1 = acc[ai][bj][m][1];
                    float* o = out + (e < 512 ? O_MK : O_MV) + ((size_t)l * 1024 + row) * 512 + (e & 511);
                    *(f32x4*)o = a0; *(f32x4*)(o + 4) = a1;
                    v4u w; w.x = pk2(a0[0], a0[1]); w.y = pk2(a0[2], a0[3]); w.z = pk2(a1[0], a1[1]); w.w = pk2(a1[2], a1[3]);
                    *(v4u*)(MKB + ((size_t)l * 1024 + row) * 1024 + e) = w; } }
    }
};
typedef short s16x4 __attribute__((ext_vector_type(4)));
typedef short v4i16_t __attribute__((ext_vector_type(4)));
#define MFMA16(a, b, c) __builtin_amdgcn_mfma_f32_16x16x32_bf16((a), (b), (c), 0, 0, 0)
constexpr float LOG2E = 1.4426950408889634f;
__device__ __forceinline__ s16x4 ds_tr(LAS unsigned char* p) { return __builtin_bit_cast(s16x4, __builtin_amdgcn_ds_read_tr16_b64_v4i16((LAS v4i16_t*)p)); }
__device__ __forceinline__ bf16x8 frag_tr(LAS unsigned char* base, int rowA, int rowB, int c0, int pitch, int tq, int tp) {
    const s16x4 lo = ds_tr(base + (rowA + tq) * pitch + (c0 + 4 * tp) * 2), hi = ds_tr(base + (rowB + tq) * pitch + (c0 + 4 * tp) * 2);
    return __builtin_shufflevector(lo, hi, 0, 1, 2, 3, 4, 5, 6, 7);
}
__device__ __forceinline__ bf16x8 pack_bf8(f32x4 a, f32x4 b) { v4u w; w.x = pk2(a[0], a[1]); w.y = pk2(a[2], a[3]); w.z = pk2(b[0], b[1]); w.w = pk2(b[2], b[3]); return __builtin_bit_cast(bf16x8, w); }

constexpr int KP = 272;
constexpr int VP2 = 528;
__device__ __forceinline__ void attn_unit(LAS unsigned char* lds, int tid, const bf16* Qb, int ldq, int nqt, const bf16* K0, const bf16* K1, const bf16* V0, const bf16* V1, int ldk,
                                          bf16* Ob, int ldo, int lo, int hi, int kmin, const float* sinks) {
    const int lane = tid & 63, w = __builtin_amdgcn_readfirstlane(tid >> 6), r16 = lane & 15, g = lane >> 4, tq = r16 >> 2, tp = r16 & 3;
    LAS unsigned char* Kt = lds; LAS unsigned char* Vt = lds + 256 * KP;
    __syncthreads();
#pragma unroll
    for (int it = 0; it < 8; ++it) { const int row = it * 32 + (tid >> 4), ch = tid & 15;
        const v4u kv = *(const v4u*)((row < 128 ? K0 : K1) + (size_t)(row & 127) * ldk + ch * 8), vv = *(const v4u*)((row < 128 ? V0 : V1) + (size_t)(row & 127) * ldk + ch * 8);
        *(LAS v4u*)(Kt + row * KP + ch * 16) = kv; *(LAS v4u*)(Vt + row * KP + ch * 16) = vv; }
    __syncthreads();
    int klo = 16 * w + lo; if (klo < kmin) klo = kmin; if (klo < 0) klo = 0; int khi = 16 * w + 15 + hi; if (khi > 255) khi = 255;
    const int nt_lo = klo >> 4, nt_hi = khi >> 4;
    const int qi = 16 * w + r16;
    for (int qt = 0; qt < nqt; ++qt) {
        const bf16* qp = Qb + (size_t)qi * ldq + qt * 128 + 8 * g;
        bf16x8 qf[4];
#pragma unroll
        for (int ks = 0; ks < 4; ++ks) qf[ks] = *(const bf16x8*)(qp + 32 * ks);
        f32x4 s[16];
#pragma unroll
        for (int nt = 0; nt < 16; ++nt) { s[nt] = (f32x4){0.f, 0.f, 0.f, 0.f};
            if (nt >= nt_lo && nt <= nt_hi) {
#pragma unroll
                for (int ks = 0; ks < 4; ++ks) { const bf16x8 kf = *(const LAS bf16x8*)(Kt + (16 * nt + r16) * KP + (32 * ks + 8 * g) * 2); s[nt] = MFMA16(kf, qf[ks], s[nt]); } } }
        const float NEG = -__builtin_inff(); float mx = NEG;
#pragma unroll
        for (int nt = 0; nt < 16; ++nt)
#pragma unroll
            for (int r = 0; r < 4; ++r) { const int kk = 16 * nt + 4 * g + r; const bool ok = (nt >= nt_lo) && (nt <= nt_hi) && (kk >= kmin) && (kk >= qi + lo) && (kk <= qi + hi);
                const float v = ok ? s[nt][r] * (QSCALE * LOG2E) : NEG; s[nt][r] = v; mx = fmaxf(mx, v); }
        mx = fmaxf(mx, __shfl_xor(mx, 16)); mx = fmaxf(mx, __shfl_xor(mx, 32));
        const float snk = sinks ? sinks[qt] * LOG2E : NEG;
        const float M = fmaxf(mx, snk); float l = 0.f;
#pragma unroll
        for (int nt = 0; nt < 16; ++nt)
#pragma unroll
            for (int r = 0; r < 4; ++r) { const float p = __builtin_amdgcn_exp2f(s[nt][r] - M); s[nt][r] = p; l += p; }
        l += __shfl_xor(l, 16); l += __shfl_xor(l, 32); l += __builtin_amdgcn_exp2f(snk - M);
        const float il = 1.0f / l;
        f32x4 o[8];
#pragma unroll
        for (int mt = 0; mt < 8; ++mt) o[mt] = (f32x4){0.f, 0.f, 0.f, 0.f};
#pragma unroll
        for (int ks = 0; ks < 8; ++ks) {
            if (2 * ks + 1 >= nt_lo && 2 * ks <= nt_hi) {
                const bf16x8 pf = pack_bf8(s[2 * ks], s[2 * ks + 1]);
#pragma unroll
                for (int mt = 0; mt < 8; ++mt) { const bf16x8 vf = frag_tr(Vt, 32 * ks + 4 * g, 32 * ks + 16 + 4 * g, 16 * mt, KP, tq, tp); o[mt] = MFMA16(vf, pf, o[mt]); } } }
        bf16* op = Ob + (size_t)qi * ldo + qt * 128 + 4 * g;
#pragma unroll
        for (int mt = 0; mt < 8; ++mt) { uint2 u; u.x = pk2(o[mt][0] * il, o[mt][1] * il); u.y = pk2(o[mt][2] * il, o[mt][3] * il); *(uint2*)(op + 16 * mt) = u; }
    }
}
__device__ __forceinline__ void ph_attn_mfma(const Frame& F, const Args& a, int L, bool is_swa, int tf) {
    const bf16* QB = (const bf16*)(a.ws + WS_QKVB); bf16* OCAT = (bf16*)(a.ws + WS_OCAT); const bf16* MKB = (const bf16*)(a.ws + WS_MEMKB) + (size_t)L * 1024 * 1024;
    const int pitch = is_swa ? SWA_IN : RET_IN, qoff = is_swa ? 2560 : 4608, j = L / 2;
    const int n_swa = is_swa ? NB * 4 * 16 : 0, n_all = n_swa + NB * 4 * 16;
    for (int u = F.bid - tf; u < n_all; u += F.G - tf) {
        if (u < 0) break;
        if (u < n_swa) { const int qb = u % 16, kvh = (u / 16) % 4, b = u / 64; const size_t r1 = (size_t)b * SEQ + 128 * qb, r0 = qb ? r1 - 128 : r1;
            const bf16* kb = QB + 1536 + kvh * 128;
            attn_unit(F.lds, F.tid, QB + r1 * SWA_IN + 3 * kvh * 128, SWA_IN, 3, kb + r0 * SWA_IN, kb + r1 * SWA_IN, kb + 512 + r0 * SWA_IN, kb + 512 + r1 * SWA_IN, SWA_IN,
                      OCAT + r1 * D + 3 * kvh * 128, D, 0, 128, qb ? 0 : 128, a.in[15] + j * 12 + 3 * kvh);
        } else { const int uu = u - n_swa, qb = uu % 16, h = (uu / 16) % 4, b = uu / 64; const size_t r1 = (size_t)b * SEQ + 128 * qb;
            const bf16* kb = MKB + (size_t)(b * 256) * 1024 + h * 128;
            attn_unit(F.lds, F.tid, QB + r1 * pitch + qoff + h * 128, pitch, 1, kb, kb + (size_t)128 * 1024, kb + 512, kb + 512 + (size_t)128 * 1024, 1024,
                      OCAT + r1 * D + 1536 + h * 128, D, -1024, 1024, 0, nullptr);
        }
    }
    __syncthreads();
}
template <int NH, int NKW, bool EXTRA>
__device__ __forceinline__ void decode_unit(LAS unsigned char* lds, int tid, const float* qp, const float* kc, const float* vc, const float* kx, const float* vx, const float* sinks,
                                            bf16* op, float* kout, float* vout) {
    const int lane = tid & 63, w = __builtin_amdgcn_readfirstlane(tid >> 6);
    LAS float* pm = (LAS float*)lds; LAS float* pa = pm + 64;
    f32x2_t q[NH], kr[NKW], vr[NKW], kxr = {0.f, 0.f}, vxr = {0.f, 0.f};
#pragma unroll
    for (int h = 0; h < NH; ++h) q[h] = *(const f32x2_t*)(qp + 128 * h);
#pragma unroll
    for (int i = 0; i < NKW; ++i) { const size_t j = (size_t)(w * NKW + i) * 512; kr[i] = *(const f32x2_t*)(kc + j); vr[i] = *(const f32x2_t*)(vc + j); }
    const bool ext = EXTRA && w == 7;
    if (ext) { kxr = *(const f32x2_t*)kx; vxr = *(const f32x2_t*)vx; }
    if (kout) {
#pragma unroll
        for (int i = 0; i < NKW; ++i) { const int j = w * NKW + i; if (j >= 1) { *(f32x2_t*)(kout + (size_t)(j - 1) * 512) = kr[i]; *(f32x2_t*)(vout + (size_t)(j - 1) * 512) = vr[i]; } }
        if (ext) { *(f32x2_t*)(kout + (size_t)(8 * NKW - 1) * 512) = kxr; *(f32x2_t*)(vout + (size_t)(8 * NKW - 1) * 512) = vxr; }
    }
    __syncthreads();
#pragma unroll
    for (int h = 0; h < NH; ++h) {
        float s[NKW], m = -1e30f, sx = -1e30f;
#pragma unroll
        for (int i = 0; i < NKW; ++i) { s[i] = wave_sum(q[h].x * kr[i].x + q[h].y * kr[i].y) * QSCALE; m = fmaxf(m, s[i]); }
        if (ext) { sx = wave_sum(q[h].x * kxr.x + q[h].y * kxr.y) * QSCALE; m = fmaxf(m, sx); }
        float l = 0.f; f32x2_t acc = {0.f, 0.f};
#pragma unroll
        for (int i = 0; i < NKW; ++i) { const float pp = __expf(s[i] - m); l += pp; acc += vr[i] * pp; }
        if (ext) { const float pp = __expf(sx - m); l += pp; acc += vxr * pp; }
        if (lane == 0) { pm[(w * NH + h) * 2] = m; pm[(w * NH + h) * 2 + 1] = l; }
        *(LAS f32x2_t*)(pa + (w * NH + h) * 128 + 2 * lane) = acc;
    }
    __syncthreads();
    if (w < NH) { const int h = w; const float sk = sinks ? sinks[h] : -1e30f; float M = sk;
#pragma unroll
        for (int ww = 0; ww < 8; ++ww) M = fmaxf(M, pm[(ww * NH + h) * 2]);
        float den = sinks ? __expf(sk - M) : 0.f; f32x2_t o = {0.f, 0.f};
#pragma unroll
        for (int ww = 0; ww < 8; ++ww) { const float f = __expf(pm[(ww * NH + h) * 2] - M); den += f * pm[(ww * NH + h) * 2 + 1]; o += *(const LAS f32x2_t*)(pa + (ww * NH + h) * 128 + 2 * lane) * f; }
        const float id = 1.0f / den; *(unsigned*)(op + 128 * h) = pk2(o.x * id, o.y * id); }
    __syncthreads();
}
__device__ __forceinline__ void ph_attn_sample(const Frame& F, const Args& a, int L, bool is_swa, int tf) {
    const int lane = F.lane, j = L / 2;
    const float* QKV = (const float*)(a.ws + WS_QKV); bf16* OCAT = (bf16*)(a.ws + WS_OCAT);
    const int pitch = is_swa ? SWA_IN : RET_IN, qoff = is_swa ? 2560 : 4608;
    const float* CMK = a.in[5] + (size_t)L * SB * 256 * 512; const float* CMV = a.in[6] + (size_t)L * SB * 256 * 512;
    const float* CK = a.in[2] + (size_t)j * SB * 128 * 512; const float* CV = a.in[3] + (size_t)j * SB * 128 * 512;
    const int n2 = is_swa ? SB * 4 : 0, n3 = n2 + SB * 4;
    for (int u = F.bid - tf; u < n3; u += F.G - tf) {
        if (u < n2) { const int kvh = u % 4, b = u / 4; const size_t row = (size_t)MP + b, co = ((size_t)b * 128) * 512 + kvh * 128 + 2 * lane;
            const float* kx = QKV + row * SWA_IN + 1536 + kvh * 128 + 2 * lane;
            decode_unit<3, 16, true>(F.lds, F.tid, QKV + row * SWA_IN + 3 * kvh * 128 + 2 * lane, CK + co, CV + co, kx, kx + 512, a.in[15] + j * 12 + 3 * kvh, OCAT + row * D + 3 * kvh * 128 + 2 * lane,
                                     a.out + O_SKS + (size_t)j * SB * 128 * 512 + co, a.out + O_SVS + (size_t)j * SB * 128 * 512 + co);
        } else { const int uu = u - n2, h = uu % 4, b = uu / 4; const size_t row = (size_t)MP + b, co = ((size_t)b * 256) * 512 + h * 128 + 2 * lane;
            decode_unit<1, 32, false>(F.lds, F.tid, QKV + row * pitch + qoff + h * 128 + 2 * lane, CMK + co, CMV + co, nullptr, nullptr, nullptr, OCAT + row * D + 1536 + h * 128 + 2 * lane, nullptr, nullptr);
        }
    }
}
__device__ __forceinline__ void ph_ret_r1(const Frame& F, const Args& a) {
    const bf16* QB = (const bf16*)(a.ws + WS_QKVB); float* DST = (float*)(a.ws + WS_DST);
    const int tid = F.tid, lane = F.lane, w = F.wave, r16 = lane & 15, g = lane >> 4, tq = r16 >> 2, tp = r16 & 3;
    LAS unsigned char* Kt = F.lds; LAS unsigned char* Vt = F.lds + 128 * KP;
    for (int u2 = F.bid; u2 < NB * 6 * 16 * 2; u2 += F.G) {
        const int hf = u2 & 1, u = u2 >> 1, c = u % 16, h = (u / 16) % 6, b = u / 96; const size_t row0 = (size_t)b * SEQ + 128 * c;
        const float lg = log2f(1.0f - exp2f(-5.0f - (float)h));
        __syncthreads();
#pragma unroll
        for (int it = 0; it < 4; ++it) { const int row = it * 32 + (tid >> 4), ch = tid & 15;
            const v4u kv = *(const v4u*)(QB + (row0 + row) * RET_IN + 768 + h * 128 + ch * 8);
            const float f = exp2f((float)(127 - row) * lg);
            v4u o; o.x = pk2(bf2f(kv.x & 0xffff) * f, bf2f(kv.x >> 16) * f); o.y = pk2(bf2f(kv.y & 0xffff) * f, bf2f(kv.y >> 16) * f);
            o.z = pk2(bf2f(kv.z & 0xffff) * f, bf2f(kv.z >> 16) * f); o.w = pk2(bf2f(kv.w & 0xffff) * f, bf2f(kv.w >> 16) * f);
            *(LAS v4u*)(Kt + row * KP + ch * 16) = o;
            *(LAS v4u*)(Vt + row * KP + ch * 16) = *(const v4u*)(QB + (row0 + row) * RET_IN + 1536 + h * 256 + 128 * hf + ch * 8); }
        __syncthreads();
        f32x4 acc[8];
#pragma unroll
        for (int nt = 0; nt < 8; ++nt) acc[nt] = (f32x4){0.f, 0.f, 0.f, 0.f};
#pragma unroll
        for (int ks = 0; ks < 4; ++ks) {
            const bf16x8 af = frag_tr(Vt, 32 * ks + 8 * g, 32 * ks + 8 * g + 4, 16 * w, KP, tq, tp);
#pragma unroll
            for (int nt = 0; nt < 8; ++nt) { const bf16x8 bfr = frag_tr(Kt, 32 * ks + 8 * g, 32 * ks + 8 * g + 4, 16 * nt, KP, tq, tp); acc[nt] = MFMA16(af, bfr, acc[nt]); } }
        float* dp = DST + (size_t)u * 32768 + (size_t)(128 * hf + 16 * w + 4 * g) * 128 + r16;
#pragma unroll
        for (int nt = 0; nt < 8; ++nt)
#pragma unroll
            for (int r = 0; r < 4; ++r) dp[(size_t)r * 128 + 16 * nt] = acc[nt][r];
    }
    __syncthreads();
}
__device__ __forceinline__ void ph_ret_r2(const Frame& F, const Args& a, int jr) {
    const float* DST = (const float*)(a.ws + WS_DST); bf16* SC = (bf16*)(a.ws + WS_SC); float* so = a.out + O_RSP + (size_t)jr * NB * 6 * 32768;
    LAS float* tl = (LAS float*)(F.lds + RING_OFF);
    const int tid = F.tid, ntile = NB * 6 * 16;
    for (int t = F.bid; t < ntile; t += F.G) {
        const int bh = t >> 4, dv0 = (t & 15) * 16, h = bh % 6, e = dv0 * 128 + 4 * tid;
        const float cdec = exp2f(128.0f * log2f(1.0f - exp2f(-5.0f - (float)h)));
        f32x4 d[16];
#pragma unroll
        for (int c = 0; c < 16; ++c) d[c] = *(const f32x4*)(DST + ((size_t)bh * 16 + c) * 32768 + e);
        f32x4 S = {0.f, 0.f, 0.f, 0.f};
#pragma unroll
        for (int c = 0; c < 16; ++c) { uint2 o; o.x = pk2(S[0], S[1]); o.y = pk2(S[2], S[3]); *(uint2*)(SC + ((size_t)bh * 16 + c) * 32768 + e) = o; S = S * cdec + d[c]; }
        __syncthreads();
        { const int dvl = tid >> 5, dk = (tid & 31) * 4; LAS float* w = tl + dvl * 129 + dk; w[0] = S[0]; w[1] = S[1]; w[2] = S[2]; w[3] = S[3]; }
        __syncthreads();
#pragma unroll
        for (int k = 0; k < 4; ++k) { const int idx = tid + 512 * k, dk = idx >> 4, dvl = idx & 15; so[(size_t)bh * 32768 + (size_t)dk * 256 + dv0 + dvl] = tl[dvl * 129 + dk]; }
    }
    __syncthreads();
}
__device__ __forceinline__ void ph_ret_r3(const Frame& F, const Args& a) {
    const bf16* QB = (const bf16*)(a.ws + WS_QKVB); const bf16* SC = (const bf16*)(a.ws + WS_SC); bf16* OCAT = (bf16*)(a.ws + WS_OCAT);
    const int tid = F.tid, lane = F.lane, w = F.wave, r16 = lane & 15, g = lane >> 4, tq = r16 >> 2, tp = r16 & 3;
    LAS unsigned char* Kt = F.lds; LAS unsigned char* St = F.lds + 128 * KP; LAS unsigned char* Vt = F.lds + 128 * KP;
    for (int u = F.bid; u < NB * 6 * 16; u += F.G) {
        const int c = u % 16, h = (u / 16) % 6, b = u / 96; const size_t row0 = (size_t)b * SEQ + 128 * c;
        const float lg = log2f(1.0f - exp2f(-5.0f - (float)h));
        __syncthreads();
#pragma unroll
        for (int it = 0; it < 4; ++it) { const int row = it * 32 + (tid >> 4), ch = tid & 15;
            *(LAS v4u*)(Kt + row * KP + ch * 16) = *(const v4u*)(QB + (row0 + row) * RET_IN + 768 + h * 128 + ch * 8); }
#pragma unroll
        for (int it = 0; it < 8; ++it) { const int row = it * 32 + (tid >> 4), ch = tid & 15;
            *(LAS v4u*)(St + row * KP + ch * 16) = *(const v4u*)(SC + (size_t)u * 32768 + (size_t)row * 128 + ch * 8); }
        __syncthreads();
        const int ti = 16 * w + r16;
        const bf16* qp = QB + (row0 + ti) * RET_IN + h * 128 + 8 * g;
        bf16x8 qf[4];
#pragma unroll
        for (int ks = 0; ks < 4; ++ks) qf[ks] = *(const bf16x8*)(qp + 32 * ks);
        f32x4 s[8];
#pragma unroll
        for (int nt = 0; nt < 8; ++nt) { s[nt] = (f32x4){0.f, 0.f, 0.f, 0.f};
            if (nt <= w) {
#pragma unroll
                for (int ks = 0; ks < 4; ++ks) { const bf16x8 kf = *(const LAS bf16x8*)(Kt + (16 * nt + r16) * KP + (32 * ks + 8 * g) * 2); s[nt] = MFMA16(kf, qf[ks], s[nt]); }
#pragma unroll
                for (int r = 0; r < 4; ++r) { const int sk = 16 * nt + 4 * g + r; s[nt][r] = (sk <= ti) ? s[nt][r] * exp2f(-(float)(sk + 1) * lg) : 0.f; } } }
        f32x4 acc[16];
#pragma unroll
        for (int mt = 0; mt < 16; ++mt) { acc[mt] = (f32x4){0.f, 0.f, 0.f, 0.f};
#pragma unroll
            for (int ks = 0; ks < 4; ++ks) { const bf16x8 sf = *(const LAS bf16x8*)(St + (16 * mt + r16) * KP + (32 * ks + 8 * g) * 2); acc[mt] = MFMA16(sf, qf[ks], acc[mt]); } }
        __syncthreads();
#pragma unroll
        for (int it = 0; it < 8; ++it) { const int row = it * 16 + (tid >> 5), ch = tid & 31;
            *(LAS v4u*)(Vt + row * VP2 + ch * 16) = *(const v4u*)(QB + (row0 + row) * RET_IN + 1536 + h * 256 + ch * 8); }
        __syncthreads();
#pragma unroll
        for (int ks = 0; ks < 4; ++ks) {
            if (2 * ks <= w) {
                const bf16x8 pf = pack_bf8(s[2 * ks], s[2 * ks + 1]);
#pragma unroll
                for (int mt = 0; mt < 16; ++mt) { const bf16x8 vf = frag_tr(Vt, 32 * ks + 4 * g, 32 * ks + 16 + 4 * g, 16 * mt, VP2, tq, tp); acc[mt] = MFMA16(vf, pf, acc[mt]); } } }
        const float qd = exp2f((float)(ti + 1) * lg); float sum = 0.f;
#pragma unroll
        for (int mt = 0; mt < 16; ++mt) { acc[mt] = acc[mt] * qd; sum += (acc[mt][0] + acc[mt][1]) + (acc[mt][2] + acc[mt][3]); }
        sum += __shfl_xor(sum, 16); sum += __shfl_xor(sum, 32);
        const float mean = sum * (1.f / 256.f); float sq = 0.f;
#pragma unroll
        for (int mt = 0; mt < 16; ++mt) { acc[mt] = acc[mt] - mean; sq += (acc[mt][0] * acc[mt][0] + acc[mt][1] * acc[mt][1]) + (acc[mt][2] * acc[mt][2] + acc[mt][3] * acc[mt][3]); }
        sq += __shfl_xor(sq, 16); sq += __shfl_xor(sq, 32);
        const float rstd = 1.0f / sqrtf(sq * (1.f / 256.f) + HN_EPS);
        const bf16* gp = QB + (row0 + ti) * RET_IN + 3072 + h * 256 + 4 * g; bf16* op = OCAT + (row0 + ti) * D + h * 256 + 4 * g;
        uint2 gate[16];
#pragma unroll
        for (int mt = 0; mt < 16; ++mt) gate[mt] = *(const uint2*)(gp + 16 * mt);
#pragma unroll
        for (int mt = 0; mt < 16; ++mt) { const uint2 gg = gate[mt];
            uint2 o; o.x = pk2(silu_f(bf2f(gg.x & 0xffff)) * acc[mt][0] * rstd, silu_f(bf2f(gg.x >> 16)) * acc[mt][1] * rstd);
            o.y = pk2(silu_f(bf2f(gg.y & 0xffff)) * acc[mt][2] * rstd, silu_f(bf2f(gg.y >> 16)) * acc[mt][3] * rstd);
            *(uint2*)(op + 16 * mt) = o; }
    }
    __syncthreads();
}
__device__ __forceinline__ void ph_ret_sample(const Frame& F, const Args& a, int jr) {
    const float* QKV = (const float*)(a.ws + WS_QKV); float* ORAW = (float*)(a.ws + WS_ORAW);
    LAS float* qs = (LAS float*)(F.lds + RING_OFF); LAS float* ks = qs + 128; LAS float* po = qs + 256;
    const int dv = F.tid & 255, hf = F.tid >> 8;
    for (int u = F.G - 1 - F.bid; u < SB * 6; u += F.G) {
        const int seq = u / 6, h = u % 6; const size_t row = (size_t)MP + seq;
        const float* S0 = a.in[4] + (size_t)jr * SB * 6 * 32768; float* Sout = a.out + O_RSS + (size_t)jr * SB * 6 * 32768;
        const float gamma = 1.0f - exp2f(-5.0f - (float)h);
        const size_t so = (size_t)(seq * 6 + h) * 32768 + (size_t)(64 * hf) * 256 + dv;
        const float* p = QKV + row * RET_IN;
        __syncthreads();
        if (F.tid < 128) qs[F.tid] = p[h * 128 + F.tid]; else if (F.tid < 256) ks[F.tid - 128] = p[768 + h * 128 + (F.tid - 128)];
        const float v = p[1536 + h * 256 + dv];
        __syncthreads();
        float o = 0.f;
#pragma unroll
        for (int i0 = 0; i0 < 64; i0 += 32) {
            float s0[32];
#pragma unroll
            for (int j = 0; j < 32; ++j) s0[j] = S0[so + (size_t)(i0 + j) * 256];
#pragma unroll
            for (int j = 0; j < 32; ++j) { const int i = 64 * hf + i0 + j; const float sn = gamma * s0[j] + ks[i] * v; Sout[so + (size_t)(i0 + j) * 256] = sn; o += qs[i] * sn; }
        }
        if (hf) po[dv] = o;
        __syncthreads();
        if (!hf) ORAW[row * 1536 + h * 256 + dv] = o + po[dv];
    }
    __syncthreads();
}

#ifndef WBITS
#define WBITS 5
#endif
__device__ __forceinline__ unsigned f2bfw(float f) { constexpr unsigned sh = 23 - WBITS; unsigned u = __builtin_bit_cast(unsigned, f); u += ((1u << (sh - 1)) - 1u) + ((u >> sh) & 1u); return (u >> sh) << (sh - 16); }
__device__ __forceinline__ unsigned pkw(float lo, float hi) { return f2bfw(lo) | (f2bfw(hi) << 16); }
__device__ __forceinline__ void conv_load(float (&r)[64], const float* wu, int pitch, int lane) {
#pragma unroll
    for (int kk = 0; kk < 64; ++kk) r[kk] = __builtin_nontemporal_load((wu + (size_t)kk * pitch) + lane);
}
__device__ __forceinline__ void conv_proc(const float (&r)[64], LAS float* scr, int lane, bf16* wt, int K, const float* gain, const float* bias, float (&c1)[8], float& c2, bool coarse) {
#pragma unroll
    for (int kk = 0; kk < 64; ++kk) { float gk = 1.f; if (gain) { gk = gain[kk]; c2 += bias[kk] * r[kk]; } scr[kk * 65 + lane] = r[kk] * gk; }
    LDS_WAIT();
    const int c = lane & 7;
#pragma unroll
    for (int j = 0; j < 8; ++j) { const int n = (lane >> 3) + 8 * j; const LAS float* s = scr + (8 * c) * 65 + n;
        v4u o; if (coarse) { o.x = pkw(s[0 * 65], s[1 * 65]); o.y = pkw(s[2 * 65], s[3 * 65]); o.z = pkw(s[4 * 65], s[5 * 65]); o.w = pkw(s[6 * 65], s[7 * 65]); }
        else { o.x = pk2(s[0 * 65], s[1 * 65]); o.y = pk2(s[2 * 65], s[3 * 65]); o.z = pk2(s[4 * 65], s[5 * 65]); o.w = pk2(s[6 * 65], s[7 * 65]); }
        *(v4u*)(wt + (size_t)n * K + 8 * c) = o;
#pragma unroll
        for (int q = 0; q < 4; ++q) c1[j] += bf2f(o[q] & 0xffffu) + bf2f(o[q] >> 16); }
    LDS_WAIT();
}
__device__ __forceinline__ void conv_item(LAS float* scr, int lane, const float* W, int K, int pitch, int col0, bf16* WT, int row0, int kb0, int nkb, const float* gain, const float* bias, float* c1p, float* c2p, bool coarse) {
    float c1[8] = {0.f, 0.f, 0.f, 0.f, 0.f, 0.f, 0.f, 0.f}, c2 = 0.f;
    const float* wp = W + (size_t)(64 * kb0) * pitch + col0; bf16* wt = WT + (size_t)row0 * K + 64 * kb0;
    const float* gp = gain ? gain + 64 * kb0 : nullptr; const float* bp = gain ? bias + 64 * kb0 : nullptr;
    float ra[64], rb[64];
    conv_load(ra, wp, pitch, lane);
    for (int i = 0; i < nkb; i += 2) {
        const bool h1 = i + 1 < nkb, h2 = i + 2 < nkb;
        if (h1) conv_load(rb, wp + (size_t)64 * (i + 1) * pitch, pitch, lane);
        conv_proc(ra, scr, lane, wt + 64 * i, K, gp ? gp + 64 * i : nullptr, gp ? bp + 64 * i : nullptr, c1, c2, coarse);
        if (h1) { if (h2) conv_load(ra, wp + (size_t)64 * (i + 2) * pitch, pitch, lane);
            conv_proc(rb, scr, lane, wt + 64 * (i + 1), K, gp ? gp + 64 * (i + 1) : nullptr, gp ? bp + 64 * (i + 1) : nullptr, c1, c2, coarse); }
    }
    if (c1p) {
#pragma unroll
        for (int j = 0; j < 8; ++j) { float t = c1[j]; t += __shfl_xor(t, 1); t += __shfl_xor(t, 2); t += __shfl_xor(t, 4); c1[j] = t; }
        if ((lane & 7) == 0) {
#pragma unroll
            for (int j = 0; j < 8; ++j) c1p[(lane >> 3) + 8 * j] = c1[j]; }
        c2p[lane] = c2;
    }
}
__device__ __forceinline__ void ph_prologue(const Frame& F, const Args& a) {
    unsigned char* ws = a.ws; const int lane = F.lane;
    LAS float* scr = (LAS float*)(F.lds + RING_OFF + F.wave * 16640);
    constexpr int NB_GU = NGU / 64, NB_INS = SWA_IN / 64, NB_INR = RET_IN / 64;
    constexpr int N_BIG = 8 * NB_GU + 2 * NB_INS + 2 * NB_INR;
    constexpr int I_OUT = 4 * (D / 64) * 2, I_MEM = 4 * (1024 / 64) * 2, I_DN = 8 * (D / 64) * 32;
    constexpr int N_ALL = N_BIG + I_OUT + I_MEM + I_DN;
    bf16* Z0 = zbuf(ws, 0);
    for (size_t i = F.gtid; i < (size_t)MP * D / 4; i += F.ngt) { const float4 v = ((const float4*)a.in[0])[i]; uint2 o; o.x = pk2(v.x, v.y); o.y = pk2(v.z, v.w); ((uint2*)Z0)[i] = o; }
    for (size_t i = F.gtid; i < (size_t)SB * D / 4; i += F.ngt) { const float4 v = ((const float4*)a.in[1])[i]; uint2 o; o.x = pk2(v.x, v.y); o.y = pk2(v.z, v.w); ((uint2*)(Z0 + (size_t)MP * D))[i] = o; }
    for (size_t i = F.gtid; i < (size_t)1024 * D / 4; i += F.ngt) { const float4 v = ((const float4*)a.in[7])[i]; uint2 o; o.x = pk2(v.x, v.y); o.y = pk2(v.z, v.w); ((uint2*)(ws + WS_XMEMB))[i] = o; }
    { long long* st0 = stbuf(ws, 0); for (size_t i = F.gtid; i < (size_t)MP; i += F.ngt) { st0[2 * i] = 0; st0[2 * i + 1] = __float2ll_rn((float)D * (1.0f - LN_EPS) * ST_SCALE); }
      float* on = (float*)(ws + WS_ONES); for (size_t i = F.gtid; i < (size_t)2 * D; i += F.ngt) on[i] = i < (size_t)D ? 1.f : 0.f; }
    { float* rp = (float*)(ws + WS_ROPE);
      for (size_t i = F.gtid; i < (size_t)SEQ * 16; i += F.ngt) { const int pos = (int)(i >> 4), ii = (int)(i & 15); const float inv = powf(500000.0f, -(float)ii / 16.0f), ang = (float)pos * inv;
          float sn, cs; sincosf(ang, &sn, &cs); rp[2 * i] = cs; rp[2 * i + 1] = sn; }
      float* rr = (float*)(ws + WS_RETCS);
      for (size_t i = F.gtid; i < (size_t)SEQ * 64; i += F.ngt) { const int pos = (int)(i >> 6), ii = (int)(i & 63); const float an = powf(10000.0f, -((float)ii / 63.0f)), ang = (float)pos * an;
          float sn, cs; sincosf(ang, &sn, &cs); rr[2 * i] = cs; rr[2 * i + 1] = sn; } }
    unsigned* qword = (unsigned*)(ws + WS_CTL) + CW_Q;
    volatile LAS unsigned* tk = (volatile LAS unsigned*)(F.lds + LDSCTL_OFF + 64);
    for (;;) {
        __syncthreads();
        if (F.tid == 0) *tk = atomicAdd(qword, 8u);
        __syncthreads();
        const unsigned qb = *tk; if (qb >= (unsigned)N_ALL) break;
        const unsigned q = qb + (unsigned)F.wave; if (q >= (unsigned)N_ALL) continue;
        int r = (int)q;
        const float* W; int K = D, pitch, col0, row0, kb0 = 0, nkb = D / 64, v = 0; bf16* WT; float* c1p = nullptr; float* c2p = nullptr; bool coarse = true;
        if (r < N_BIG) {
            if (r < 8 * NB_GU) { const int m = r / NB_GU, nb = r % NB_GU, L = m >> 1, s = m & 1; v = 3 * L + (s ? 2 : 0);
                W = a.in[10] + (size_t)m * D * NGU; pitch = NGU; WT = (bf16*)(ws + WS_WGU) + (size_t)m * NGU * D; row0 = 64 * nb;
                const int pn = row0 >> 8, o = row0 & 255; col0 = o < 128 ? 128 * pn + o : DFF + 128 * pn + (o - 128);
                c1p = (float*)(ws + WS_C1GU) + (size_t)m * NGU + row0; c2p = c1p + (size_t)8 * NGU; }
            else if ((r -= 8 * NB_GU) < 2 * NB_INS) { const int m = r / NB_INS, nb = r % NB_INS; v = 3 * (2 * m) + 1; coarse = false;
                W = a.in[13] + (size_t)m * D * SWA_IN; pitch = SWA_IN; WT = (bf16*)(ws + WS_WINS) + (size_t)m * SWA_IN * D; row0 = 64 * nb; col0 = row0;
                c1p = (float*)(ws + WS_C1INS) + (size_t)m * SWA_IN + row0; c2p = c1p + (size_t)2 * SWA_IN; }
            else { r -= 2 * NB_INS; const int m = r / NB_INR, nb = r % NB_INR; v = 3 * (2 * m + 1) + 1; coarse = false;
                W = a.in[16] + (size_t)m * D * RET_IN; pitch = RET_IN; WT = (bf16*)(ws + WS_WINR) + (size_t)m * RET_IN * D; row0 = 64 * nb; col0 = row0;
                c1p = (float*)(ws + WS_C1INR) + (size_t)m * RET_IN + row0; c2p = c1p + (size_t)2 * RET_IN; }
        } else if ((r -= N_BIG) < I_OUT) { const int nb = r % (D / 64), kr = (r / (D / 64)) & 1, m = r / (2 * (D / 64));
            W = ((m & 1) ? a.in[17] : a.in[14]) + (size_t)(m >> 1) * D * D; pitch = D; WT = (bf16*)(ws + WS_WOUT) + (size_t)m * D * D; row0 = col0 = 64 * nb; kb0 = 16 * kr; nkb = 16;
        } else if ((r -= I_OUT) < I_MEM) { const int nb = r % (1024 / 64), kr = (r / (1024 / 64)) & 1, m = r / (2 * (1024 / 64)); coarse = false;
            W = a.in[12] + (size_t)m * D * 1024; pitch = 1024; WT = (bf16*)(ws + WS_WMEM) + (size_t)m * 1024 * D; row0 = col0 = 64 * nb; kb0 = 16 * kr; nkb = 16;
        } else { r -= I_MEM; const int nb = r % (D / 64), kr = (r / (D / 64)) & 31, m = r / (32 * (D / 64));
            W = a.in[11] + (size_t)m * DFF * D; K = DFF; pitch = D; WT = (bf16*)(ws + WS_WDN) + (size_t)m * D * DFF; row0 = col0 = 64 * nb; kb0 = kr < 24 ? 3 * kr : 72 + 2 * (kr - 24); nkb = kr < 24 ? 3 : 2;
        }
        conv_item(scr, lane, W, K, pitch, col0, WT, row0, kb0, nkb, v ? lngain(a, v) : nullptr, v ? lnbias(a, v) : nullptr, c1p, c2p, coarse);
    }
}

__device__ __forceinline__ void sample_stats(const Frame& F, const bf16* Zs, bool identity) {
    LAS f32x2_t* sst = (LAS f32x2_t*)(F.lds + SSTAT_OFF);
    const int row = F.tid >> 4, sub = F.tid & 15; float sum = 0.f, sq = 0.f;
#pragma unroll 4
    for (int i = 0; i < 16; ++i) { const v4u z = *(const v4u*)(Zs + (size_t)row * D + 8 * (sub + 16 * i));
#pragma unroll
        for (int q = 0; q < 4; ++q) { const float lo = bf2f(z[q] & 0xffffu), hi = bf2f(z[q] >> 16); sum += lo + hi; sq += lo * lo + hi * hi; } }
#pragma unroll
    for (int o = 1; o < 16; o <<= 1) { sum += __shfl_xor(sum, o); sq += __shfl_xor(sq, o); }
    const float mu = sum * (1.f / D), var = sq * (1.f / D) - mu * mu;
    __syncthreads();
    if (sub == 0) sst[row] = identity ? (f32x2_t){0.f, 1.f} : (f32x2_t){mu, 1.0f / sqrtf(fmaxf(var, 0.f) + LN_EPS)};
    __syncthreads();
}
struct SEpi { const float* c1; const float* c2; bf16* H; const bf16* Zo; bf16* Zn; const float* g; const float* b; float* QS; float s; int pad; };
template <int KIND> __device__ __forceinline__ void ph_sgemm(const Frame& F, const bf16* A, const bf16* Bt, int N, int K, const SEpi& E, int tf) {
    const int tid = F.tid, lane = F.lane, w = F.wave, r16 = lane & 15, g = lane >> 4;
    LAS float* red = (LAS float*)F.lds;
    const LAS f32x2_t* sst = (const LAS f32x2_t*)(F.lds + SSTAT_OFF);
    const int nitems = N / 32, kw = K / 8;
    for (int it = F.bid - tf; it < nitems; it += F.G - tf) {
        if (it < 0) break;
        int r0, r1; if (KIND == 0) { r0 = 256 * (it >> 3) + 16 * (it & 7); r1 = r0 + 128; } else { r0 = 32 * it; r1 = r0 + 16; }
        f32x4 acc[2][2];
#pragma unroll
        for (int m = 0; m < 2; ++m)
#pragma unroll
            for (int t = 0; t < 2; ++t) acc[m][t] = (f32x4){0.f, 0.f, 0.f, 0.f};
        const bf16* ap = A + (size_t)r16 * K + w * kw + 16 * g;
        const bf16* bp0 = Bt + (size_t)(r0 + r16) * K + w * kw + 16 * g; const bf16* bp1 = Bt + (size_t)(r1 + r16) * K + w * kw + 16 * g;
#pragma unroll 4
        for (int kc = 0; kc < kw; kc += 64) {
            bf16x8 af[2][2], bfr[2][2];
#pragma unroll
            for (int s2 = 0; s2 < 2; ++s2) { af[0][s2] = *(const bf16x8*)(ap + kc + 8 * s2); af[1][s2] = *(const bf16x8*)(ap + (size_t)16 * K + kc + 8 * s2);
                bfr[0][s2] = *(const bf16x8*)(bp0 + kc + 8 * s2); bfr[1][s2] = *(const bf16x8*)(bp1 + kc + 8 * s2); }
#pragma unroll
            for (int s2 = 0; s2 < 2; ++s2)
#pragma unroll
                for (int m = 0; m < 2; ++m)
#pragma unroll
                    for (int t = 0; t < 2; ++t) acc[m][t] = MFMA16(af[m][s2], bfr[t][s2], acc[m][t]);
        }
        __syncthreads();
#pragma unroll
        for (int m = 0; m < 2; ++m)
#pragma unroll
            for (int t = 0; t < 2; ++t)
#pragma unroll
                for (int r = 0; r < 4; ++r) red[(w * 32 + 16 * m + 4 * g + r) * 32 + 16 * t + r16] = acc[m][t][r];
        __syncthreads();
        const int row = tid >> 4, cp = tid & 15; float v0 = 0.f, v1 = 0.f;
#pragma unroll
        for (int ww = 0; ww < 8; ++ww) { v0 += red[(ww * 32 + row) * 32 + cp]; v1 += red[(ww * 32 + row) * 32 + 16 + cp]; }
        const f32x2_t st = sst[row];
        if (KIND == 0) {
            const float gg = st.y * (v0 - st.x * E.c1[r0 + cp]) + E.c2[r0 + cp], uu = st.y * (v1 - st.x * E.c1[r1 + cp]) + E.c2[r1 + cp];
            E.H[(size_t)row * DFF + 128 * (it >> 3) + 16 * (it & 7) + cp] = (bf16)f2bf(silu_f(gg) * uu);
        } else if (KIND == 1) {
#pragma unroll
            for (int t = 0; t < 2; ++t) { const int col = r0 + 16 * t + cp; const float zo = bf2f(E.Zo[(size_t)row * D + col]);
                E.Zn[(size_t)row * D + col] = (bf16)f2bf(ALPHA * ((zo - st.x) * st.y * E.g[col] + E.b[col]) + E.s * (t ? v1 : v0)); }
        } else {
            constexpr int N_ = KIND == 2 ? SWA_IN : RET_IN;
            float x0 = st.y * (v0 - st.x * E.c1[r0 + cp]) + E.c2[r0 + cp], x1 = st.y * (v1 - st.x * E.c1[r1 + cp]) + E.c2[r1 + cp];
            if (KIND == 2) {
                if (r0 < 2048 && (r0 & 127) == 0) {
                    const float inv = powf(500000.0f, -(float)cp / 16.0f); float sn, cs; sincosf((float)PAST * inv, &sn, &cs);
                    const float a0 = x0 * cs - x1 * sn, a1 = x1 * cs + x0 * sn; x0 = a0; x1 = a1; }
            } else {
                if (r0 < 1536) {
                    const float sc = r0 < 768 ? 1.0f : QSCALE;
#pragma unroll
                    for (int t = 0; t < 2; ++t) { float& x = t ? x1 : x0; const int col = r0 + 16 * t + cp; const float an = powf(10000.0f, -((float)((col & 127) >> 1) / 63.0f));
                        float sn, cs; sincosf((float)PAST * an, &sn, &cs); const float o = __shfl_xor(x, 1);
                        x = ((cp & 1) ? x * cs + o * sn : x * cs - o * sn) * sc; }
                }
            }
            E.QS[(size_t)row * N_ + r0 + cp] = x0; E.QS[(size_t)row * N_ + r1 + cp] = x1;
        }
    }
    __syncthreads();
}
__device__ __forceinline__ void ph_final(const Frame& F, const Args& a) {
    const bf16* Z = zbuf(a.ws, 12); const long long* st = stbuf(a.ws, 12); const float* g = lngain(a, 12); const float* b = lnbias(a, 12); const int lane = F.lane;
    f32x4 gv[4][2], bv[4][2];
#pragma unroll
    for (int j = 0; j < 4; ++j)
#pragma unroll
        for (int q = 0; q < 2; ++q) { gv[j][q] = *(const f32x4*)(g + 8 * (lane + 64 * j) + 4 * q); bv[j][q] = *(const f32x4*)(b + 8 * (lane + 64 * j) + 4 * q); }
    for (int r = F.gw; r < MR; r += F.ngw) {
        v4u z[4];
#pragma unroll
        for (int j = 0; j < 4; ++j) z[j] = *(const v4u*)(Z + (size_t)r * D + 8 * (lane + 64 * j));
        float mu, rs;
        if (r < MP) row_stats(st, r, mu, rs);
        else { float sum = 0.f, sq = 0.f;
#pragma unroll
            for (int j = 0; j < 4; ++j)
#pragma unroll
                for (int q = 0; q < 4; ++q) { const float lo = bf2f(z[j][q] & 0xffffu), hi = bf2f(z[j][q] >> 16); sum += lo + hi; sq += lo * lo + hi * hi; }
            sum = wave_sum(sum); sq = wave_sum(sq); mu = sum * (1.f / D); rs = 1.0f / sqrtf(fmaxf(sq * (1.f / D) - mu * mu, 0.f) + LN_EPS); }
#pragma unroll
        for (int j = 0; j < 4; ++j) { const int c = 8 * (lane + 64 * j); f32x4 o0, o1;
#pragma unroll
            for (int q = 0; q < 2; ++q) { o0[2 * q] = (bf2f(z[j][q] & 0xffffu) - mu) * rs * gv[j][0][2 * q] + bv[j][0][2 * q]; o0[2 * q + 1] = (bf2f(z[j][q] >> 16) - mu) * rs * gv[j][0][2 * q + 1] + bv[j][0][2 * q + 1];
                o1[2 * q] = (bf2f(z[j][2 + q] & 0xffffu) - mu) * rs * gv[j][1][2 * q] + bv[j][1][2 * q]; o1[2 * q + 1] = (bf2f(z[j][2 + q] >> 16) - mu) * rs * gv[j][1][2 * q + 1] + bv[j][1][2 * q + 1]; }
            float* op = a.out + O_YP + (size_t)r * D + c; *(f32x4*)op = o0; *(f32x4*)(op + 4) = o1; }
    }
}
__device__ __forceinline__ void ph_headnorm_gate(const Frame& F, const float* ORAW, const float* QKV, bf16* OCAT, int row_off, int rows) {
    const int lane = F.lane; const int nw = rows * 6;
    for (int w = F.gw; w < nw; w += F.ngw) {
        const int h = w % 6; const size_t row = (size_t)row_off + w / 6;
        const float4 o = *(const float4*)(ORAW + row * 1536 + h * 256 + 4 * lane);
        const float mean = wave_sum((o.x + o.y) + (o.z + o.w)) * (1.f / 256.f);
        const float dx = o.x - mean, dy = o.y - mean, dz = o.z - mean, dw = o.w - mean;
        const float rstd = 1.0f / sqrtf(wave_sum((dx * dx + dy * dy) + (dz * dz + dw * dw)) * (1.f / 256.f) + HN_EPS);
        const float4 g = *(const float4*)(QKV + row * RET_IN + 3072 + h * 256 + 4 * lane);
        uint2 p; p.x = pk2(silu_f(g.x) * dx * rstd, silu_f(g.y) * dy * rstd); p.y = pk2(silu_f(g.z) * dz * rstd, silu_f(g.w) * dw * rstd);
        *(uint2*)(OCAT + row * D + h * 256 + 4 * lane) = p;
    }
}

__device__ __forceinline__ Frame mkframe(LAS unsigned char* lds) {
    Frame F; int t = threadIdx.x; asm volatile("" : "+v"(t));
    F.lds = lds; F.tid = t; F.lane = t & 63; F.wave = __builtin_amdgcn_readfirstlane(t >> 6);
    F.G = gridDim.x; F.bid = blockIdx.x;
    F.gtid = (size_t)F.bid * NTHR + F.tid; F.ngt = (size_t)F.G * NTHR; F.gw = F.bid * NWAVES + F.wave; F.ngw = F.G * NWAVES;
    return F;
}
#define GRID_BAR() xcd_barrier(bar)
__device__ __forceinline__ void sub_barrier(unsigned* cnt, unsigned n) {
    asm volatile("s_waitcnt vmcnt(0)" ::: "memory");
    __syncthreads();
    if (threadIdx.x == 0) {
        __builtin_amdgcn_fence(__ATOMIC_RELEASE, "agent");
        asm volatile("s_waitcnt vmcnt(0)" ::: "memory");
        xb_add(cnt, 1u);
        unsigned sp = 0;
        while (xb_ld(cnt) < n) { __builtin_amdgcn_s_sleep(1); if (++sp > (1u << 22)) break; }
        __builtin_amdgcn_fence(__ATOMIC_ACQUIRE, "agent");
        asm volatile("s_waitcnt vmcnt(0)" ::: "memory");
    }
    __syncthreads();
}
template <class Epi> __device__ __forceinline__ void run_gemm(const Frame& F, const bf16* A, const bf16* Bt, int M, int N, int K, const Epi& E, int cshift) {
    pg8::Gemm g; g.A = A; g.Bt = Bt; g.M = M; g.N = N; g.K = K;
    pg8::StaticOrder S; S.init(M, N, F.G, (F.bid + cshift) % F.G);
    pg8::gemm_phase<Epi, pg8::StaticOrder, true, true>(F.lds + RING_OFF, g, S, E);
}
template <int S> __device__ __forceinline__ void ffn_step(const Args& a, LAS unsigned char* lds, const XcdBarrier& bar, int L, bool with_mem) {
    unsigned char* ws = a.ws; const Frame F = mkframe(lds);
    const int wi = 2 * L + S, v = 3 * L + (S ? 2 : 0);
    const bf16* Zc = zbuf(ws, v); bf16* Zn = zbuf(ws, v + 1); bf16* H = (bf16*)(ws + WS_H);
    const bf16* wgu = (const bf16*)(ws + WS_WGU) + (size_t)wi * NGU * D; const bf16* wdn = (const bf16*)(ws + WS_WDN) + (size_t)wi * D * DFF;
    const float* c1 = (const float*)(ws + WS_C1GU) + (size_t)wi * NGU; const float* c2 = c1 + (size_t)8 * NGU;
    { EpiGU E; E.H = H; E.st = stbuf(ws, v); E.c1 = c1; E.c2 = c2; run_gemm(F, Zc, wgu, MP, NGU, D, E, 0); }
    if (with_mem) { EpiMem E; E.out = a.out; E.MKB = (bf16*)(ws + WS_MEMKB); run_gemm(F, (const bf16*)(ws + WS_XMEMB), (const bf16*)(ws + WS_WMEM), 1024, 4096, D, E, F.G / 2); }
    const int tf = with_mem ? (3 * F.G) / 4 : F.G / 2;
    if (F.bid >= tf) { sample_stats(F, Zc + (size_t)MP * D, v == 0);
        { SEpi E{}; E.c1 = c1; E.c2 = c2; E.H = H + (size_t)MP * DFF; ph_sgemm<0>(F, Zc + (size_t)MP * D, wgu, NGU, D, E, tf); }
        sub_barrier((unsigned*)(ws + WS_CTL) + 1024 + 32 * wi, (unsigned)(F.G - tf));
        { SEpi E{}; E.Zo = Zc + (size_t)MP * D; E.Zn = Zn + (size_t)MP * D; E.g = lngain(a, v); E.b = lnbias(a, v); E.s = 0.5f; ph_sgemm<1>(F, H + (size_t)MP * DFF, wdn, D, DFF, E, tf); } }
    GRID_BAR();
    { EpiRes E; E.Zo = Zc; E.Zn = Zn; E.sto = stbuf(ws, v); E.stn = stbuf(ws, v + 1); E.g = lngain(a, v); E.b = lnbias(a, v); E.s = 0.5f; E.pad = 0; run_gemm(F, H, wdn, MP, D, DFF, E, 0); }
    GRID_BAR();
}
template <int L> __device__ __forceinline__ void layer(const Args& a, LAS unsigned char* lds, const XcdBarrier& bar) {
    constexpr int j = L / 2; constexpr bool is_swa = (L & 1) == 0; constexpr int nin = is_swa ? SWA_IN : RET_IN, v = 3 * L + 1;
    ffn_step<0>(a, lds, bar, L, L == 0);
    {
        unsigned char* ws = a.ws; const Frame F = mkframe(lds);
        const bf16* Zc = zbuf(ws, v); bf16* Zn = zbuf(ws, v + 1); float* QKV = (float*)(ws + WS_QKV); float* ORAW = (float*)(ws + WS_ORAW); bf16* OCAT = (bf16*)(ws + WS_OCAT);
        const bf16* win = is_swa ? (const bf16*)(ws + WS_WINS) + (size_t)j * SWA_IN * D : (const bf16*)(ws + WS_WINR) + (size_t)j * RET_IN * D;
        const float* c1 = is_swa ? (const float*)(ws + WS_C1INS) + (size_t)j * SWA_IN : (const float*)(ws + WS_C1INR) + (size_t)j * RET_IN; const float* c2 = c1 + 2 * nin;
        { EpiIn<is_swa ? 0 : 1> E; E.QB = (bf16*)(ws + WS_QKVB); E.st = stbuf(ws, v); E.c1 = c1; E.c2 = c2; E.rope = (const f32x4*)(ws + WS_ROPE); E.retcs = (const f32x4*)(ws + WS_RETCS); E.out = a.out; E.jl = j; E.pad = 0;
          run_gemm(F, Zc, win, MP, nin, D, E, 0); }
        if (F.bid >= F.G / 2) { sample_stats(F, Zc + (size_t)MP * D, false);
            { SEpi E{}; E.c1 = c1; E.c2 = c2; E.QS = QKV + (size_t)MP * nin; ph_sgemm<is_swa ? 2 : 3>(F, Zc + (size_t)MP * D, win, nin, D, E, F.G / 2); }
            if (!is_swa) { sub_barrier((unsigned*)(ws + WS_CTL) + 1024 + 32 * (12 + L), (unsigned)(F.G - F.G / 2));
                ph_attn_sample(F, a, L, false, F.G / 2); } }
        GRID_BAR();
        if (is_swa) {
            ph_attn_mfma(F, a, L, true, 0);
            ph_attn_sample(F, a, L, true, 0);
        } else {
            ph_ret_r1(F, a);
            GRID_BAR();
            ph_ret_r2(F, a, j);
            ph_ret_sample(F, a, j);
            GRID_BAR();
            ph_ret_r3(F, a);
            ph_attn_mfma(F, a, L, false, F.G / 2);
            ph_headnorm_gate(F, ORAW, QKV, OCAT, MP, SB);
        }
        GRID_BAR();
        const bf16* wout = (const bf16*)(ws + WS_WOUT) + (size_t)L * D * D;
        if (F.bid < D / 32 || F.G < D / 32) { sample_stats(F, Zc + (size_t)MP * D, false);
            SEpi E{}; E.Zo = Zc + (size_t)MP * D; E.Zn = Zn + (size_t)MP * D; E.g = lngain(a, v); E.b = lnbias(a, v); E.s = 1.0f; ph_sgemm<1>(F, OCAT + (size_t)MP * D, wout, D, D, E, 0); }
        { EpiRes E; E.Zo = Zc; E.Zn = Zn; E.sto = stbuf(ws, v); E.stn = stbuf(ws, v + 1); E.g = lngain(a, v); E.b = lnbias(a, v); E.s = 1.0f; E.pad = 0; run_gemm(F, OCAT, wout, MP, D, D, E, 0); }
        GRID_BAR();
    }
    ffn_step<1>(a, lds, bar, L, false);
}
__global__ void __launch_bounds__(NTHR, 2) mega(Args a) {
    extern __shared__ __attribute__((aligned(16))) unsigned char lds_raw[];
    LAS unsigned char* lds = (LAS unsigned char*)lds_raw;
    for (int u = threadIdx.x; u < (LDS_BYTES - LDSCTL_OFF) / 4; u += NTHR) ((LAS unsigned*)(lds + LDSCTL_OFF))[u] = 0u;
    __syncthreads();
    volatile LAS unsigned* MISC = (volatile LAS unsigned*)(lds + MISC_OFF);
    const XcdBarrier bar = xcd_barrier_post((unsigned*)(a.ws + WS_CTL) + CW_BAR, MISC + 8);
    { const Frame F = mkframe(lds); ph_prologue(F, a); GRID_BAR(); }
    layer<0>(a, lds, bar);
    layer<1>(a, lds, bar);
    layer<2>(a, lds, bar);
    layer<3>(a, lds, bar);
    { const Frame F = mkframe(lds); ph_final(F, a); }
}

extern "C" void kernel_launch(void* const* d_in, const int* in_sizes, int n_in, void* d_out, int out_size, void* d_ws, size_t ws_size, hipStream_t stream) {
    static int grid = 0;
    if (grid == 0) {
        if (n_in != 18 || (size_t)out_size != O_END || ws_size < WS_END) { fprintf(stderr, "kernel_launch: unexpected sizes n_in %d out %d ws %zu (need %zu)\n", n_in, out_size, ws_size, (size_t)WS_END); grid = -1; return; }
        int dev = 0, cus = 0, per_cu = 0;
        if (hipGetDevice(&dev) != hipSuccess || hipDeviceGetAttribute(&cus, hipDeviceAttributeMultiprocessorCount, dev) != hipSuccess) { grid = -1; return; }
        if (hipFuncSetAttribute((const void*)mega, hipFuncAttributeMaxDynamicSharedMemorySize, LDS_BYTES) != hipSuccess) { fprintf(stderr, "kernel_launch: hipFuncSetAttribute failed\n"); grid = -1; return; }
        if (hipOccupancyMaxActiveBlocksPerMultiprocessor(&per_cu, (const void*)mega, NTHR, LDS_BYTES) != hipSuccess || per_cu < 1) { fprintf(stderr, "kernel_launch: occupancy query says %d blocks per CU\n", per_cu); grid = -1; return; }
        (void)hipGetLastError();
        grid = cus;
    }
    if (grid < 0) return;
    if (hipMemsetAsync((char*)d_ws + WS_CTL, 0, CTL_BYTES, stream) != hipSuccess) { fprintf(stderr, "kernel_launch: memset failed\n"); return; }
    Args a{};
    for (int i = 0; i < 18; ++i) a.in[i] = (const float*)d_in[i];
    a.out = (float*)d_out; a.ws = (unsigned char*)d_ws;
    hipLaunchKernelGGL(mega, dim3(grid), dim3(NTHR), LDS_BYTES, stream, a);
}
```

```cpp
#include <hip/hip_runtime.h>
#include <cstdio>
#include <cstdint>
namespace pg8 {
#define PG8_LAS __attribute__((address_space(3)))
typedef unsigned short bf16_t;
typedef short bf16x8 __attribute__((ext_vector_type(8)));
typedef float f32x4 __attribute__((ext_vector_type(4)));
typedef unsigned u32x4 __attribute__((ext_vector_type(4)));
constexpr int BM = 256, BK = 64, HALF = 128, HTB = HALF * BK * 2  , STAGE_BYTES = 8 * HTB, NXCD = 8, WGM = 8;

__host__ __device__ __forceinline__ int lds_byte(int r, int c) { const int st = (r >> 4) * 2 + (c >> 5), rr = r & 15, cc = c & 31, ob = rr * 64 + cc * 2; return st * 1024 + (ob ^ (((ob >> 9) & 1) << 5)); }
__host__ __device__ __forceinline__ void stage_rc(int b, int& R, int& C) { const int st = b / 1024, sb = b % 1024, swz = sb ^ (((sb >> 9) & 1) << 5); R = (st >> 1) * 16 + swz / 64; C = (st & 1) * 32 + (swz % 64) / 2; }
__host__ __device__ __forceinline__ int perm32(int rho) { const int n = rho >> 4, i = rho & 15; return 8 * (i >> 2) + 4 * n + (i & 3); }

struct Unit { int pm, pn; };
struct Gemm { const bf16_t* A; const bf16_t* Bt; int M, N, K; };

struct StaticOrder {
    int nM, nN, nwg, G, c;
    __host__ __device__ void init(int M, int N, int G_, int c_) { nM = M / BM; nN = N / BM; nwg = nM * nN; G = G_; c = c_; }
    __host__ __device__ bool next(int i, Unit& u) const {
        const long L = (long)i * G + c; if (L >= nwg) return false;
        int wgid = (int)L; { const int q = nwg / NXCD, r = nwg % NXCD, xcd = wgid % NXCD, off = wgid / NXCD; wgid = (xcd < r ? xcd * (q + 1) : r * (q + 1) + (xcd - r) * q) + off; }
        const int nig = WGM * nN, gid = wgid / nig, fm = gid * WGM, gsz = (nM - fm) < WGM ? (nM - fm) : WGM;
        u.pm = fm + ((wgid % nig) % gsz); u.pn = (wgid % nig) / gsz; return true;
    }
    __device__ __forceinline__ void a_ready(const Unit&) const {}
    __device__ __forceinline__ void done(const Unit&) const {}
};

__device__ __forceinline__ unsigned cvt_pk_bf16(float lo, float hi) { unsigned r; asm volatile("v_cvt_pk_bf16_f32 %0, %1, %2" : "=v"(r) : "v"(lo), "v"(hi)); return r; }
typedef float f32x2 __attribute__((ext_vector_type(2)));

template <class Epi, class Sched, bool ALIGN_EPI = false, bool SP2 = false>
__device__ __forceinline__ void gemm_phase(PG8_LAS unsigned char* lds, const Gemm g, const Sched& S, const Epi& E) {
    int tid_ = threadIdx.x; asm volatile("" : "+v"(tid_)); const int tid = tid_, wid = __builtin_amdgcn_readfirstlane(tid >> 6), lane = tid & 63, wr = wid >> 2, wc = wid & 3, fr = lane & 15, fq = lane >> 4;
    const int K = g.K, nt = K / BK;
    unsigned voffA[2], voffB[2];
#pragma unroll
    for (int i = 0; i < 2; ++i) { int R, C; stage_rc(tid * 16 + i * 8192, R, C); const int Rb = Epi::PERM ? ((R & ~31) + perm32(R & 31)) : R;
        voffA[i] = (unsigned)(R * K + C) * 2u; voffB[i] = (unsigned)(Rb * K + C) * 2u; }
    const size_t kstep = (size_t)(BK * 2);
    const size_t hstep = (size_t)HALF * K * 2;
    const size_t tstep = 2 * hstep;
    const unsigned ldsw = (unsigned)wid * 1024u;
    const int aoff = lds_byte(wr * 64 + fr, fq * 8), boff = lds_byte(wc * 32 + fr, fq * 8);
#define PG8_SA(b, h) (((b) * 2 + (h)) * HTB)
#define PG8_SB(b, h) ((4 + (b) * 2 + (h)) * HTB)
#define PG8_STAGE(bufoff, gbase, voff) do { _Pragma("unroll") for (int _i = 0; _i < 2; ++_i) \
        __builtin_amdgcn_global_load_lds((const unsigned*)((const char*)(gbase) + (voff)[_i]), (PG8_LAS unsigned*)(lds + (bufoff) + ldsw + _i * 8192), 16, 0, 0); } while (0)
#define PG8_LDA(dst, b, h) do { _Pragma("unroll") for (int m = 0; m < 4; ++m) _Pragma("unroll") for (int k = 0; k < 2; ++k) dst[m][k] = *(const PG8_LAS bf16x8*)(lds + PG8_SA(b, h) + aoff + m * 2048 + k * 1024); } while (0)
#define PG8_LDB(dst, b, h) do { _Pragma("unroll") for (int n = 0; n < 2; ++n) _Pragma("unroll") for (int k = 0; k < 2; ++k) dst[n][k] = *(const PG8_LAS bf16x8*)(lds + PG8_SB(b, h) + boff + n * 2048 + k * 1024); } while (0)
#define PG8_MMA(ai, bj, At, Bt) do { __builtin_amdgcn_s_setprio(1); _Pragma("unroll") for (int m = 0; m < 4; ++m) _Pragma("unroll") for (int n = 0; n < 2; ++n) _Pragma("unroll") for (int k = 0; k < 2; ++k) \
        acc[ai][bj][m][n] = __builtin_amdgcn_mfma_f32_16x16x32_bf16(Bt[n][k], At[m][k], acc[ai][bj][m][n], 0, 0, 0); __builtin_amdgcn_s_setprio(0); } while (0)
#define PG8_WAIT_V(n) asm volatile("s_waitcnt vmcnt(" #n ")" ::: "memory")
#define PG8_WAIT_L(n) asm volatile("s_waitcnt lgkmcnt(" #n ")" ::: "memory")
#define PG8_BAR __builtin_amdgcn_s_barrier()
#define PG8_SCHED __builtin_amdgcn_sched_barrier(0)
    Unit cur, nxt; int ui = 0;
    if (!S.next(0, cur)) return;
    f32x4 acc[2][2][4][2];
#pragma unroll
    for (int a = 0; a < 2; ++a)
#pragma unroll
        for (int b = 0; b < 2; ++b)
#pragma unroll
            for (int m = 0; m < 4; ++m)
#pragma unroll
                for (int n = 0; n < 2; ++n) acc[a][b][m][n] = (f32x4){0.f, 0.f, 0.f, 0.f};
    bf16x8 At[4][2], B0[2][2], B1[2][2];
    const char* cA = (const char*)g.A + (size_t)cur.pm * tstep; const char* cB = (const char*)g.Bt + (size_t)cur.pn * tstep;
    S.a_ready(cur);
    if constexpr (SP2) {
        PG8_STAGE(PG8_SB(0, 0), cB, voffB); PG8_STAGE(PG8_SB(0, 1), cB + hstep, voffB); PG8_STAGE(PG8_SA(0, 0), cA, voffA); PG8_STAGE(PG8_SA(0, 1), cA + hstep, voffA);
        if (wr == 1) PG8_BAR;
        PG8_WAIT_V(2); PG8_BAR;
        PG8_STAGE(PG8_SB(1, 0), cB + kstep, voffB); PG8_STAGE(PG8_SA(1, 0), cA + kstep, voffA); PG8_STAGE(PG8_SB(1, 1), cB + hstep + kstep, voffB);
        PG8_WAIT_V(6); PG8_BAR;
    } else {
        PG8_STAGE(PG8_SB(0, 0), cB, voffB); PG8_STAGE(PG8_SA(0, 0), cA, voffA); PG8_STAGE(PG8_SB(0, 1), cB + hstep, voffB); PG8_STAGE(PG8_SA(0, 1), cA + hstep, voffA);
        if (wr == 1) PG8_BAR;
        PG8_WAIT_V(4); PG8_BAR;
        PG8_STAGE(PG8_SB(1, 0), cB + kstep, voffB); PG8_STAGE(PG8_SA(1, 0), cA + kstep, voffA); PG8_STAGE(PG8_SB(1, 1), cB + hstep + kstep, voffB);
        PG8_WAIT_V(6); PG8_BAR;
    }
    for (;;) {
        const bool has_next = S.next(ui + 1, nxt);
        const char* nA = has_next ? (const char*)g.A + (size_t)nxt.pm * tstep : cA; const char* nB = has_next ? (const char*)g.Bt + (size_t)nxt.pn * tstep : cB;
        for (int t = 0; t < nt; t += 2) {
            const bool last = (t == nt - 2);
            const char* a1 = cA + (size_t)(t + 1) * kstep;
            const char* a2 = last ? nA : cA + (size_t)(t + 2) * kstep; const char* b2 = last ? nB : cB + (size_t)(t + 2) * kstep;
            const char* a3 = a2 + kstep; const char* b3 = b2 + kstep;
            if (last && has_next) S.a_ready(nxt);
            if constexpr (SP2) {
            PG8_LDB(B0, 0, 0); PG8_LDB(B1, 0, 1); PG8_SCHED; PG8_LDA(At, 0, 0); PG8_STAGE(PG8_SA(1, 1), a1 + hstep, voffA);
            PG8_WAIT_V(8); PG8_WAIT_L(0); PG8_BAR; PG8_MMA(0, 0, At, B0); PG8_MMA(0, 1, At, B1); PG8_BAR; PG8_SCHED;
            PG8_LDA(At, 0, 1); PG8_STAGE(PG8_SB(0, 0), b2, voffB); PG8_STAGE(PG8_SB(0, 1), b2 + hstep, voffB); PG8_STAGE(PG8_SA(0, 0), a2, voffA);
            PG8_WAIT_V(8); PG8_WAIT_L(0); PG8_BAR; PG8_MMA(1, 0, At, B0); PG8_MMA(1, 1, At, B1); PG8_BAR; PG8_SCHED;
            PG8_LDB(B0, 1, 0); PG8_LDB(B1, 1, 1); PG8_SCHED; PG8_LDA(At, 1, 0); PG8_STAGE(PG8_SA(0, 1), a2 + hstep, voffA);
            PG8_WAIT_V(8); PG8_WAIT_L(0); PG8_BAR; PG8_MMA(0, 0, At, B0); PG8_MMA(0, 1, At, B1); PG8_BAR; PG8_SCHED;
            PG8_LDA(At, 1, 1); PG8_STAGE(PG8_SB(1, 0), b3, voffB); PG8_STAGE(PG8_SB(1, 1), b3 + hstep, voffB); PG8_STAGE(PG8_SA(1, 0), a3, voffA);
            PG8_WAIT_V(8); PG8_WAIT_L(0); PG8_BAR; PG8_MMA(1, 0, At, B0); PG8_MMA(1, 1, At, B1); PG8_BAR; PG8_SCHED;
            } else {
            PG8_LDB(B0, 0, 0); PG8_SCHED; PG8_LDA(At, 0, 0); PG8_STAGE(PG8_SA(1, 1), a1 + hstep, voffA);
            PG8_WAIT_L(8); PG8_BAR; PG8_WAIT_L(0); PG8_MMA(0, 0, At, B0); PG8_BAR; PG8_SCHED;
            PG8_LDB(B1, 0, 1); PG8_STAGE(PG8_SB(0, 0), b2, voffB);
            PG8_BAR; PG8_WAIT_L(0); PG8_MMA(0, 1, At, B1); PG8_BAR;
            PG8_LDA(At, 0, 1); PG8_STAGE(PG8_SA(0, 0), a2, voffA);
            PG8_BAR; PG8_WAIT_L(0); PG8_MMA(1, 0, At, B0); PG8_BAR; PG8_SCHED;
            PG8_STAGE(PG8_SB(0, 1), b2 + hstep, voffB);
            PG8_WAIT_V(6); PG8_BAR; PG8_MMA(1, 1, At, B1); PG8_BAR;
            PG8_LDB(B0, 1, 0); PG8_SCHED; PG8_LDA(At, 1, 0); PG8_STAGE(PG8_SA(0, 1), a2 + hstep, voffA);
            PG8_WAIT_L(8); PG8_BAR; PG8_WAIT_L(0); PG8_MMA(0, 0, At, B0); PG8_BAR; PG8_SCHED;
            PG8_LDB(B1, 1, 1); PG8_STAGE(PG8_SB(1, 0), b3, voffB);
            PG8_BAR; PG8_WAIT_L(0); PG8_MMA(0, 1, At, B1); PG8_BAR;
            PG8_LDA(At, 1, 1); PG8_STAGE(PG8_SA(1, 0), a3, voffA);
            PG8_BAR; PG8_WAIT_L(0); PG8_MMA(1, 0, At, B0); PG8_BAR; PG8_SCHED;
            PG8_STAGE(PG8_SB(1, 1), b3 + hstep, voffB);
            PG8_WAIT_V(6); PG8_BAR; PG8_MMA(1, 1, At, B1); PG8_BAR;
            }
        }
        if constexpr (ALIGN_EPI) { if (wr == 0) PG8_BAR; }
        if constexpr (!Epi::AFTER_DRAIN) { E(acc, cur, wr, wc, fr, fq); S.done(cur); }
        if (!has_next) break;
#pragma unroll
        for (int a = 0; a < 2; ++a)
#pragma unroll
            for (int b = 0; b < 2; ++b)
#pragma unroll
                for (int m = 0; m < 4; ++m)
#pragma unroll
                    for (int n = 0; n < 2; ++n) acc[a][b][m][n] = (f32x4){0.f, 0.f, 0.f, 0.f};
        cur = nxt; cA = nA; cB = nB; ++ui;
        if constexpr (ALIGN_EPI) { if (wr == 1) PG8_BAR; }
    }
    PG8_WAIT_V(0);
    if constexpr (!ALIGN_EPI) { if (wr == 0) PG8_BAR; }
    PG8_BAR;
    if constexpr (Epi::AFTER_DRAIN) { E.fused(acc, cur, wr, wc, fr, fq, lds, wid, lane); S.done(cur); }
#undef PG8_SA
#undef PG8_SB
#undef PG8_STAGE
#undef PG8_LDA
#undef PG8_LDB
#undef PG8_MMA
#undef PG8_WAIT_V
#undef PG8_WAIT_L
#undef PG8_BAR
#undef PG8_SCHED
}
}

#define GAS __attribute__((address_space(1)))
#define LAS __attribute__((address_space(3)))
typedef unsigned short bf16;
typedef unsigned v4u __attribute__((ext_vector_type(4)));
typedef float f32x4 __attribute__((ext_vector_type(4)));
typedef short bf16x8 __attribute__((ext_vector_type(8)));
typedef GAS unsigned gu32;
typedef GAS unsigned long long gu64;
#define RLX_AGENT __ATOMIC_RELAXED, __HIP_MEMORY_SCOPE_AGENT
#define LDS_WAIT() asm volatile("s_waitcnt lgkmcnt(0)" ::: "memory")
#define VM_WAIT() asm volatile("s_waitcnt vmcnt(0)" ::: "memory")
__device__ __forceinline__ unsigned long long rt() { return __builtin_amdgcn_s_memrealtime(); }
__device__ __forceinline__ unsigned f2bf(float f) { unsigned u = __builtin_bit_cast(unsigned, f); return (u + 0x7fffu + ((u >> 16) & 1u)) >> 16; }
__device__ __forceinline__ unsigned pk2(float lo, float hi) { return f2bf(lo) | (f2bf(hi) << 16); }

#define XB_TMO      128
#define XB_XCNT(j)  (256  + 64 * (j))
#define XB_XSUB(j)  (1280 + 64 * (j))
#define XB_XGEN(j)  (2304 + 64 * (j))
#define XB_TOP      3328
#define XB_TOPGEN   3392
#define XCD_BAR_WORDS 3456
#define XB_SPIN_CAP (1u << 18)

__device__ __forceinline__ unsigned xb_ld(unsigned* p)              { return __hip_atomic_load(p, __ATOMIC_RELAXED, __HIP_MEMORY_SCOPE_AGENT); }
__device__ __forceinline__ unsigned xb_add(unsigned* p, unsigned v) { return __hip_atomic_fetch_add(p, v, __ATOMIC_RELAXED, __HIP_MEMORY_SCOPE_AGENT); }
__device__ __forceinline__ unsigned xb_xcc_id() { return (unsigned)__builtin_amdgcn_s_getreg((3 << 11) | 20) & 0xFu; }
#define XB_SPIN(cond, bar) do { unsigned _sp = 0; while (cond) { __builtin_amdgcn_s_sleep(1); \
    if ((++_sp & 255u) == 0u) { if (xb_ld(&(bar)[XB_TMO])) break; if (_sp > XB_SPIN_CAP) { atomicAdd(&(bar)[XB_TMO], 1u); break; } } } } while (0)

struct XcdBarrier {
    unsigned* bar; unsigned x;
    volatile LAS unsigned* st;
};

__device__ __forceinline__ XcdBarrier xcd_barrier_post(unsigned* bar, volatile LAS unsigned* st) {
    XcdBarrier b; b.bar = bar; b.x = xb_xcc_id(); b.st = st;
    if (threadIdx.x == 0) (void)xb_add(&bar[XB_XCNT(b.x)], 1u);
    return b;
}
__device__ __forceinline__ void xcd_barrier_complete(unsigned* bar, unsigned x, unsigned& nloc, unsigned& nx) {
    const unsigned G = gridDim.x * gridDim.y * gridDim.z;
    unsigned sum, cnt, mine, sp = 0u;
    for (;;) {
        sum = 0u; cnt = 0u; mine = 0u;
#pragma unroll
        for (unsigned j = 0; j < 16; ++j) { const unsigned c = xb_ld(&bar[XB_XCNT(j)]); sum += c; cnt += (c > 0u) ? 1u : 0u; mine = (j == x) ? c : mine; }
        if (sum == G) break;
        __builtin_amdgcn_s_sleep(1);
        if ((++sp & 255u) == 0u) { if (xb_ld(&bar[XB_TMO])) break; if (sp > XB_SPIN_CAP) { atomicAdd(&bar[XB_TMO], 1u); break; } }
    }
    nloc = mine > 0u ? mine : 1u; nx = cnt > 0u ? cnt : 1u;
}

__device__ __forceinline__ void xcd_barrier(const XcdBarrier& b) {
    asm volatile("s_waitcnt vmcnt(0)" ::: "memory");
    __syncthreads();
    if (threadIdx.x == 0) {
        unsigned* bar = b.bar;
        __builtin_amdgcn_s_waitcnt(0);
        unsigned nloc = b.st[0], nx = b.st[1];
        if (nloc == 0u) { xcd_barrier_complete(bar, b.x, nloc, nx); b.st[0] = nloc; b.st[1] = nx; }
        const unsigned old = xb_add(&bar[XB_XSUB(b.x)], 1u);
        const unsigned gen = old / nloc;
        if (old + 1u == (gen + 1u) * nloc) {
            __builtin_amdgcn_fence(__ATOMIC_RELEASE, "agent");
            asm volatile("s_waitcnt vmcnt(0)" ::: "memory");
            const unsigned og = xb_add(&bar[XB_TOP], 1u);
            const unsigned tg = og / nx;
            if (og + 1u == (tg + 1u) * nx) xb_add(&bar[XB_TOPGEN], 1u);
            else XB_SPIN(xb_ld(&bar[XB_TOPGEN]) == tg, bar);
            __builtin_amdgcn_fence(__ATOMIC_ACQUIRE, "agent");
            xb_add(&bar[XB_XGEN(b.x)], 1u);
            asm volatile("s_waitcnt vmcnt(0)" ::: "memory");
        } else {
            XB_SPIN(xb_ld(&bar[XB_XGEN(b.x)]) == gen, bar);
            __builtin_amdgcn_fence(__ATOMIC_ACQUIRE, "agent");
            asm volatile("s_waitcnt vmcnt(0)" ::: "memory");
        }
    }
    __syncthreads();
}


constexpr int D = 2048, DFF = 5632, NGU = 2 * DFF, NB = 4, SEQ = 2048, MP = NB * SEQ, SB = 32, MR = MP + SB, MT = 8448;
constexpr int DEPTH = 4, PAST = 16384;
constexpr int SWA_IN = 3072, RET_IN = 5120;
constexpr float LN_EPS = 1e-5f, HN_EPS = 1e-6f;
constexpr float ALPHA = 1.6817928305074292f;
constexpr float QSCALE = 0.08838834764831845f;
constexpr int NWAVES = 8, NTHR = 512;

__device__ __forceinline__ float wave_sum(float v) {
#pragma unroll
    for (int o = 1; o < 64; o <<= 1) v += __shfl_xor(v, o);
    return v;
}
__device__ __forceinline__ float silu_f(float x) { return x * __builtin_amdgcn_rcpf(1.0f + __expf(-x)); }

constexpr size_t WS_CTL = 0, CTL_BYTES = 2u << 20;
constexpr int CW_BAR = 4096, CW_Q = 64;
constexpr size_t CTL_ST = 65536, ST_BYTES = (size_t)MP * 16;
constexpr float ST_SCALE = 16777216.0f, ST_INV = 1.0f / 16777216.0f;
__device__ __forceinline__ float ll2f(long long v) { return (float)(int)(v >> 32) * 4294967296.0f + (float)(unsigned)v; }
static_assert(CTL_ST + 13 * ST_BYTES <= CTL_BYTES, "ctl");
constexpr size_t SZ_WGU = (size_t)NGU * D * 2, SZ_WDN = (size_t)D * DFF * 2, SZ_WINS = (size_t)SWA_IN * D * 2, SZ_WINR = (size_t)RET_IN * D * 2, SZ_WOUT = (size_t)D * D * 2;
constexpr size_t WS_WGU = WS_CTL + CTL_BYTES;
constexpr size_t WS_WDN = WS_WGU + 8 * SZ_WGU;
constexpr size_t WS_WINS = WS_WDN + 8 * SZ_WDN;
constexpr size_t WS_WINR = WS_WINS + 2 * SZ_WINS;
constexpr size_t WS_WOUT = WS_WINR + 2 * SZ_WINR;
constexpr size_t WS_WMEM = WS_WOUT + 4 * SZ_WOUT;
constexpr size_t WS_C1GU = WS_WMEM + (size_t)4096 * D * 2;
constexpr size_t WS_C1INS = WS_C1GU + (size_t)2 * 8 * NGU * 4;
constexpr size_t WS_C1INR = WS_C1INS + (size_t)2 * 2 * SWA_IN * 4;
constexpr size_t WS_ONES = WS_C1INR + (size_t)2 * 2 * RET_IN * 4;
constexpr size_t WS_ROPE = WS_ONES + (size_t)2 * D * 4;
constexpr size_t WS_RETCS = WS_ROPE + (size_t)SEQ * 16 * 8;
constexpr size_t WS_XMEMB = WS_RETCS + (size_t)SEQ * 64 * 8;
constexpr size_t WS_Z = WS_XMEMB + (size_t)1024 * D * 2;
constexpr size_t SZ_Z = (size_t)MT * D * 2;
constexpr size_t WS_H = WS_Z + 2 * SZ_Z;
constexpr size_t WS_QKV = WS_H + (size_t)MT * DFF * 2;
constexpr size_t WS_ORAW = WS_QKV + (size_t)MT * RET_IN * 4;
constexpr size_t WS_OCAT = WS_ORAW + (size_t)MT * 1536 * 4;
constexpr size_t WS_QKVB = WS_OCAT + (size_t)MT * D * 2;
constexpr size_t WS_DST = WS_QKVB + (size_t)MT * RET_IN * 2;
constexpr size_t WS_SC = WS_DST + (size_t)NB * 6 * 16 * 32768 * 4;
constexpr size_t WS_MEMKB = WS_SC + (size_t)NB * 6 * 16 * 32768 * 2;
constexpr size_t WS_END = WS_MEMKB + (size_t)4 * 1024 * 1024 * 2;

constexpr size_t O_YP = 0, O_YS = O_YP + (size_t)MP * D, O_SKP = O_YS + (size_t)SB * D, O_SVP = O_SKP + 2 * 4 * 128 * 512, O_SKS = O_SVP + 2 * 4 * 128 * 512,
                 O_SVS = O_SKS + (size_t)2 * 32 * 128 * 512, O_RSP = O_SVS + (size_t)2 * 32 * 128 * 512, O_RSS = O_RSP + (size_t)2 * 4 * 6 * 128 * 256,
                 O_MK = O_RSS + (size_t)2 * 32 * 6 * 128 * 256, O_MV = O_MK + (size_t)4 * 4 * 256 * 512, O_END = O_MV + (size_t)4 * 4 * 256 * 512;

constexpr int RING_OFF = 0, RING_BYTES = 131072;
constexpr int LDSCTL_OFF = 147456, MISC_OFF = LDSCTL_OFF + 320;
constexpr int SSTAT_OFF = LDSCTL_OFF + 512;
constexpr int LDS_BYTES = LDSCTL_OFF + 1024;

struct Args { const float* in[18]; float* out; unsigned char* ws; };

struct Frame {
    LAS unsigned char* lds;
    int tid, lane, wave, G, bid;
    size_t gtid, ngt; int gw, ngw;
};
__device__ __forceinline__ bf16* zbuf(unsigned char* ws, int v) { return (bf16*)(ws + WS_Z + (size_t)(v & 1) * SZ_Z); }
__device__ __forceinline__ long long* stbuf(unsigned char* ws, int v) { return (long long*)(ws + WS_CTL + CTL_ST + (size_t)v * ST_BYTES); }
__device__ __forceinline__ const float* lngain(const Args& a, int v) { return v ? a.in[8] + (size_t)(v - 1) * D : (const float*)(a.ws + WS_ONES); }
__device__ __forceinline__ const float* lnbias(const Args& a, int v) { return v ? a.in[9] + (size_t)(v - 1) * D : (const float*)(a.ws + WS_ONES) + D; }
__device__ __forceinline__ float bf2f(unsigned h) { return __builtin_bit_cast(float, h << 16); }
__device__ __forceinline__ unsigned f2bfh(float f) { unsigned u = __builtin_bit_cast(unsigned, f); u += 0x1ffffu + ((u >> 18) & 1u); return (u >> 18) << 2; }
__device__ __forceinline__ unsigned pkh(float lo, float hi) { return f2bfh(lo) | (f2bfh(hi) << 16); }

typedef float f32x2_t __attribute__((ext_vector_type(2)));
typedef long long i64x2_t __attribute__((ext_vector_type(2)));
__device__ __forceinline__ void row_stats(const long long* st, int row, float& mu, float& rstd) {
    const i64x2_t s = *(const i64x2_t*)(st + 2 * (size_t)row); mu = ll2f(s.x) * (ST_INV / D); const float var = ll2f(s.y) * (ST_INV / D) - mu * mu; rstd = __builtin_amdgcn_rsqf(fmaxf(var, 0.f) + LN_EPS);
}
struct EpiGU {
    static constexpr bool PERM = true, AFTER_DRAIN = false;
    bf16* H; const long long* st; const float* c1; const float* c2;
    __device__ __forceinline__ void operator()(const f32x4 (&acc)[2][2][4][2], const pg8::Unit& u, int wr, int wc, int fr, int fq) const {
        const int row0 = u.pm * 256 + wr * 64 + fr, s0 = u.pn * 256 + wc * 32 + 8 * fq, hc0 = u.pn * 128 + wc * 32 + 8 * fq;
        f32x4 k1[2][2], k2[2][2];
#pragma unroll
        for (int bj = 0; bj < 2; ++bj)
#pragma unroll
            for (int n = 0; n < 2; ++n) { k1[bj][n] = *(const f32x4*)(c1 + s0 + 128 * bj + 4 * n); k2[bj][n] = *(const f32x4*)(c2 + s0 + 128 * bj + 4 * n); }
#pragma unroll
        for (int ai = 0; ai < 2; ++ai)
#pragma unroll
            for (int m = 0; m < 4; ++m) { const int row = row0 + ai * 128 + m * 16; float mu, rs; row_stats(st, row, mu, rs);
                float h[8];
#pragma unroll
                for (int n = 0; n < 2; ++n)
#pragma unroll
                    for (int e = 0; e < 4; ++e) { const float g = rs * (acc[ai][0][m][n][e] - mu * k1[0][n][e]) + k2[0][n][e], uu = rs * (acc[ai][1][m][n][e] - mu * k1[1][n][e]) + k2[1][n][e]; h[4 * n + e] = silu_f(g) * uu; }
                v4u w; w.x = pkh(h[0], h[1]); w.y = pkh(h[2], h[3]); w.z = pkh(h[4], h[5]); w.w = pkh(h[6], h[7]);
                *(v4u*)(H + (size_t)row * DFF + hc0) = w; }
    }
};
struct EpiRes {
    static constexpr bool PERM = true, AFTER_DRAIN = false;
    const bf16* Zo; bf16* Zn; const long long* sto; long long* stn; const float* g; const float* b; float s; int pad;
    __device__ __forceinline__ void operator()(const f32x4 (&acc)[2][2][4][2], const pg8::Unit& u, int wr, int wc, int fr, int fq) const {
        const int row0 = u.pm * 256 + wr * 64 + fr, c0 = u.pn * 256 + wc * 32 + 8 * fq;
#pragma unroll
        for (int bj = 0; bj < 2; ++bj) {
            const int cb = c0 + 128 * bj;
            const f32x4 ga0 = *(const f32x4*)(g + cb) * ALPHA, ga1 = *(const f32x4*)(g + cb + 4) * ALPHA, ba0 = *(const f32x4*)(b + cb) * ALPHA, ba1 = *(const f32x4*)(b + cb + 4) * ALPHA;
#pragma unroll
            for (int ai = 0; ai < 2; ++ai) {
                v4u zo4[4]; i64x2_t st4[4];
#pragma unroll
                for (int m = 0; m < 4; ++m) { const int row = row0 + ai * 128 + m * 16; zo4[m] = *(const v4u*)(Zo + (size_t)row * D + cb); st4[m] = *(const i64x2_t*)(sto + 2 * (size_t)row); }
#pragma unroll
                for (int m = 0; m < 4; ++m) { const int row = row0 + ai * 128 + m * 16;
                    const float mu = ll2f(st4[m].x) * (ST_INV / D), var = ll2f(st4[m].y) * (ST_INV / D) - mu * mu, rs = __builtin_amdgcn_rsqf(fmaxf(var, 0.f) + LN_EPS);
                    const v4u zo = zo4[m]; float z[8];
#pragma unroll
                    for (int n = 0; n < 2; ++n)
#pragma unroll
                        for (int e = 0; e < 4; ++e) { const unsigned wd = zo[2 * n + (e >> 1)]; const float zf = bf2f((e & 1) ? (wd >> 16) : (wd & 0xffffu));
                            z[4 * n + e] = (zf - mu) * rs * (n ? ga1[e] : ga0[e]) + (n ? ba1[e] : ba0[e]) + s * acc[ai][bj][m][n][e]; }
                    v4u w; w.x = pk2(z[0], z[1]); w.y = pk2(z[2], z[3]); w.z = pk2(z[4], z[5]); w.w = pk2(z[6], z[7]);
                    *(v4u*)(Zn + (size_t)row * D + cb) = w;
                    float sum = 0.f, sq = 0.f;
#pragma unroll
                    for (int q = 0; q < 4; ++q) { const float lo = bf2f(w[q] & 0xffffu), hi = bf2f(w[q] >> 16); sum += lo + hi; sq += lo * lo + hi * hi; }
                    sum += __shfl_xor(sum, 16); sum += __shfl_xor(sum, 32); sq += __shfl_xor(sq, 16); sq += __shfl_xor(sq, 32);
                    if (fq < 2 && pad == 0) __hip_atomic_fetch_add((unsigned long long*)(stn + 2 * (size_t)row + fq), (unsigned long long)__float2ll_rn((fq ? sq : sum) * ST_SCALE), __ATOMIC_RELAXED, __HIP_MEMORY_SCOPE_AGENT); }
                asm volatile("" ::: "memory");
            }
        }
    }
};
template <int KIND> struct EpiIn {
    static constexpr bool PERM = true, AFTER_DRAIN = false;
    bf16* QB; const long long* st; const float* c1; const float* c2; const f32x4* rope; const f32x4* retcs; float* out; int jl, pad;
    __device__ __forceinline__ void operator()(const f32x4 (&acc)[2][2][4][2], const pg8::Unit& u, int wr, int wc, int fr, int fq) const {
        constexpr int N = KIND == 0 ? SWA_IN : RET_IN;
        constexpr int NT = KIND == 0 ? 4 : 2;
        const int row0 = u.pm * 256 + wr * 64 + fr, c0 = u.pn * 256 + wc * 32 + 8 * fq, pn = u.pn;
        const bool rot = KIND == 0 ? (pn < 8 && wc == 0) : (pn < 6);
#pragma unroll
        for (int bj = 0; bj < 2; ++bj) {
            const int cb = c0 + 128 * bj;
            const f32x4 k10 = *(const f32x4*)(c1 + cb), k11 = *(const f32x4*)(c1 + cb + 4), k20 = *(const f32x4*)(c2 + cb), k21 = *(const f32x4*)(c2 + cb + 4);
#pragma unroll
            for (int ai = 0; ai < 2; ++ai) {
                i64x2_t st4[4];
#pragma unroll
                for (int m = 0; m < 4; ++m) st4[m] = *(const i64x2_t*)(st + 2 * (size_t)(row0 + ai * 128 + m * 16));
#pragma unroll
                for (int mp = 0; mp < 2; ++mp) {
                    f32x4 tb[2][NT];
                    if (rot) {
#pragma unroll
                        for (int q2 = 0; q2 < 2; ++q2) { const int pos = (row0 + ai * 128 + (2 * mp + q2) * 16) & (SEQ - 1);
                            const f32x4* cs = KIND == 0 ? rope + (size_t)pos * 8 + 4 * (fq & 1) : retcs + (size_t)pos * 32 + ((cb & 127) >> 2);
#pragma unroll
                            for (int q = 0; q < NT; ++q) tb[q2][q] = cs[q]; }
                    }
#pragma unroll
                    for (int q2 = 0; q2 < 2; ++q2) { const int m = 2 * mp + q2, row = row0 + ai * 128 + m * 16, pos = row & (SEQ - 1);
                        const float mu = ll2f(st4[m].x) * (ST_INV / D), var = ll2f(st4[m].y) * (ST_INV / D) - mu * mu, rs = __builtin_amdgcn_rsqf(fmaxf(var, 0.f) + LN_EPS);
                        float v[8];
#pragma unroll
                        for (int e = 0; e < 4; ++e) { v[e] = rs * (acc[ai][bj][m][0][e] - mu * k10[e]) + k20[e]; v[4 + e] = rs * (acc[ai][bj][m][1][e] - mu * k11[e]) + k21[e]; }
                        if (KIND == 0) {
                            if (rot) {
#pragma unroll
                                for (int q = 0; q < 4; ++q) { const f32x4 t = tb[q2][q];
#pragma unroll
                                    for (int hh = 0; hh < 2; ++hh) { const int jx = 2 * q + hh; const float c = hh ? t[2] : t[0], sn = hh ? t[3] : t[1]; const float o = __shfl_xor(v[jx], 32);
                                        v[jx] = (fq < 2) ? v[jx] * c - o * sn : v[jx] * c + o * sn; } }
                            }
                            if (pn >= 6 && pn < 10 && pos >= SEQ - 128) {
                                float* o = out + (pn < 8 ? O_SKP : O_SVP) + (((size_t)jl * NB + (row >> 11)) * 128 + (pos - (SEQ - 128))) * 512 + (cb - (pn < 8 ? 1536 : 2048));
                                *(f32x4*)o = (f32x4){v[0], v[1], v[2], v[3]}; *(f32x4*)(o + 4) = (f32x4){v[4], v[5], v[6], v[7]}; }
                        } else {
                            if (rot) {
                                const float sc = pn < 3 ? 1.0f : QSCALE;
#pragma unroll
                                for (int q = 0; q < 2; ++q) { const f32x4 t = tb[q2][q];
#pragma unroll
                                    for (int hh = 0; hh < 2; ++hh) { const int jx = 4 * q + 2 * hh; const float c = hh ? t[2] : t[0], sn = hh ? t[3] : t[1]; const float x1 = v[jx], x2 = v[jx + 1];
                                        v[jx] = (x1 * c - x2 * sn) * sc; v[jx + 1] = (x2 * c + x1 * sn) * sc; } }
                            }
                        }
                        v4u w; w.x = pk2(v[0], v[1]); w.y = pk2(v[2], v[3]); w.z = pk2(v[4], v[5]); w.w = pk2(v[6], v[7]);
                        *(v4u*)(QB + (size_t)row * N + cb) = w; }
                }
                asm volatile("" ::: "memory");
            }
        }
    }
};
struct EpiMem {
    static constexpr bool PERM = true, AFTER_DRAIN = false;
    float* out; bf16* MKB;
    __device__ __forceinline__ void operator()(const f32x4 (&acc)[2][2][4][2], const pg8::Unit& u, int wr, int wc, int fr, int fq) const {
        const int row0 = u.pm * 256 + wr * 64 + fr, l = u.pn >> 2, e0 = (u.pn & 3) * 256 + wc * 32 + 8 * fq;
#pragma unroll
        for (int ai = 0; ai < 2; ++ai)
#pragma unroll
            for (int m = 0; m < 4; ++m) { const int row = row0 + ai * 128 + m * 16;
#pragma unroll
                for (int bj = 0; bj < 2; ++bj) { const int e = e0 + 128 * bj; const f32x4 a0 = acc[ai][bj][m][0], a1 = acc[ai][bj][m][1];
                    float* o = out + (e < 512 ? O_MK : O_MV) + ((size_t)l * 1024 + row) * 512 + (e & 511);
                    *(f32x4*)o = a0; *(f32x4*)(o + 4) = a1;
                    v4u w; w.x = pk2(a0[0], a0[1]); w.y = pk2(a0[2], a0[3]); w.z = pk2(a1[0], a1[1]); w.w = pk2(a1[2], a1[3]);
                    *(v4u*)(MKB + ((size_t)l * 1024 + row) * 1024 + e) = w; } }
    }
};
typedef short s16x4 __attribute__((ext_vector_type(4)));
typedef short v4i16_t __attribute__((ext_vector_type(4)));
#define MFMA16(a, b, c) __builtin_amdgcn_mfma_f32_16x16x32_bf16((a), (b), (c), 0, 0, 0)
constexpr float LOG2E = 1.4426950408889634f;
__device__ __forceinline__ s16x4 ds_tr(LAS unsigned char* p) { return __builtin_bit_cast(s16x4, __builtin_amdgcn_ds_read_tr16_b64_v4i16((LAS v4i16_t*)p)); }
__device__ __forceinline__ bf16x8 frag_tr(LAS unsigned char* base, int rowA, int rowB, int c0, int pitch, int tq, int tp) {
    const s16x4 lo = ds_tr(base + (rowA + tq) * pitch + (c0 + 4 * tp) * 2), hi = ds_tr(base + (rowB + tq) * pitch + (c0 + 4 * tp) * 2);
    return __builtin_shufflevector(lo, hi, 0, 1, 2, 3, 4, 5, 6, 7);
}
__device__ __forceinline__ bf16x8 pack_bf8(f32x4 a, f32x4 b) { v4u w; w.x = pk2(a[0], a[1]); w.y = pk2(a[2], a[3]); w.z = pk2(b[0], b[1]); w.w = pk2(b[2], b[3]); return __builtin_bit_cast(bf16x8, w); }

constexpr int KP = 272;
constexpr int VP2 = 528;
__device__ __forceinline__ void attn_unit(LAS unsigned char* lds, int tid, const bf16* Qb, int ldq, int nqt, const bf16* K0, const bf16* K1, const bf16* V0, const bf16* V1, int ldk,
                                          bf16* Ob, int ldo, int lo, int hi, int kmin, const float* sinks) {
    const int lane = tid & 63, w = __builtin_amdgcn_readfirstlane(tid >> 6), r16 = lane & 15, g = lane >> 4, tq = r16 >> 2, tp = r16 & 3;
    LAS unsigned char* Kt = lds; LAS unsigned char* Vt = lds + 256 * KP;
    __syncthreads();
#pragma unroll
    for (int it = 0; it < 8; ++it) { const int row = it * 32 + (tid >> 4), ch = tid & 15;
        const v4u kv = *(const v4u*)((row < 128 ? K0 : K1) + (size_t)(row & 127) * ldk + ch * 8), vv = *(const v4u*)((row < 128 ? V0 : V1) + (size_t)(row & 127) * ldk + ch * 8);
        *(LAS v4u*)(Kt + row * KP + ch * 16) = kv; *(LAS v4u*)(Vt + row * KP + ch * 16) = vv; }
    __syncthreads();
    int klo = 16 * w + lo; if (klo < kmin) klo = kmin; if (klo < 0) klo = 0; int khi = 16 * w + 15 + hi; if (khi > 255) khi = 255;
    const int nt_lo = klo >> 4, nt_hi = khi >> 4;
    const int qi = 16 * w + r16;
    for (int qt = 0; qt < nqt; ++qt) {
        const bf16* qp = Qb + (size_t)qi * ldq + qt * 128 + 8 * g;
        bf16x8 qf[4];
#pragma unroll
        for (int ks = 0; ks < 4; ++ks) qf[ks] = *(const bf16x8*)(qp + 32 * ks);
        f32x4 s[16];
#pragma unroll
        for (int nt = 0; nt < 16; ++nt) { s[nt] = (f32x4){0.f, 0.f, 0.f, 0.f};
            if (nt >= nt_lo && nt <= nt_hi) {
#pragma unroll
                for (int ks = 0; ks < 4; ++ks) { const bf16x8 kf = *(const LAS bf16x8*)(Kt + (16 * nt + r16) * KP + (32 * ks + 8 * g) * 2); s[nt] = MFMA16(kf, qf[ks], s[nt]); } } }
        const float NEG = -__builtin_inff(); float mx = NEG;
#pragma unroll
        for (int nt = 0; nt < 16; ++nt)
#pragma unroll
            for (int r = 0; r < 4; ++r) { const int kk = 16 * nt + 4 * g + r; const bool ok = (nt >= nt_lo) && (nt <= nt_hi) && (kk >= kmin) && (kk >= qi + lo) && (kk <= qi + hi);
                const float v = ok ? s[nt][r] * (QSCALE * LOG2E) : NEG; s[nt][r] = v; mx = fmaxf(mx, v); }
        mx = fmaxf(mx, __shfl_xor(mx, 16)); mx = fmaxf(mx, __shfl_xor(mx, 32));
        const float snk = sinks ? sinks[qt] * LOG2E : NEG;
        const float M = fmaxf(mx, snk); float l = 0.f;
#pragma unroll
        for (int nt = 0; nt < 16; ++nt)
#pragma unroll
            for (int r = 0; r < 4; ++r) { const float p = __builtin_amdgcn_exp2f(s[nt][r] - M); s[nt][r] = p; l += p; }
        l += __shfl_xor(l, 16); l += __shfl_xor(l, 32); l += __builtin_amdgcn_exp2f(snk - M);
        const float il = 1.0f / l;
        f32x4 o[8];
#pragma unroll
        for (int mt = 0; mt < 8; ++mt) o[mt] = (f32x4){0.f, 0.f, 0.f, 0.f};
#pragma unroll
        for (int ks = 0; ks < 8; ++ks) {
            if (2 * ks + 1 >= nt_lo && 2 * ks <= nt_hi) {
                const bf16x8 pf = pack_bf8(s[2 * ks], s[2 * ks + 1]);
#pragma unroll
                for (int mt = 0; mt < 8; ++mt) { const bf16x8 vf = frag_tr(Vt, 32 * ks + 4 * g, 32 * ks + 16 + 4 * g, 16 * mt, KP, tq, tp); o[mt] = MFMA16(vf, pf, o[mt]); } } }
        bf16* op = Ob + (size_t)qi * ldo + qt * 128 + 4 * g;
#pragma unroll
        for (int mt = 0; mt < 8; ++mt) { uint2 u; u.x = pk2(o[mt][0] * il, o[mt][1] * il); u.y = pk2(o[mt][2] * il, o[mt][3] * il); *(uint2*)(op + 16 * mt) = u; }
    }
}
__device__ __forceinline__ void ph_attn_mfma(const Frame& F, const Args& a, int L, bool is_swa, int tf) {
    const bf16* QB = (const bf16*)(a.ws + WS_QKVB); bf16* OCAT = (bf16*)(a.ws + WS_OCAT); const bf16* MKB = (const bf16*)(a.ws + WS_MEMKB) + (size_t)L * 1024 * 1024;
    const int pitch = is_swa ? SWA_IN : RET_IN, qoff = is_swa ? 2560 : 4608, j = L / 2;
    const int n_swa = is_swa ? NB * 4 * 16 : 0, n_all = n_swa + NB * 4 * 16;
    for (int u = F.bid - tf; u < n_all; u += F.G - tf) {
        if (u < 0) break;
        if (u < n_swa) { const int qb = u % 16, kvh = (u / 16) % 4, b = u / 64; const size_t r1 = (size_t)b * SEQ + 128 * qb, r0 = qb ? r1 - 128 : r1;
            const bf16* kb = QB + 1536 + kvh * 128;
            attn_unit(F.lds, F.tid, QB + r1 * SWA_IN + 3 * kvh * 128, SWA_IN, 3, kb + r0 * SWA_IN, kb + r1 * SWA_IN, kb + 512 + r0 * SWA_IN, kb + 512 + r1 * SWA_IN, SWA_IN,
                      OCAT + r1 * D + 3 * kvh * 128, D, 0, 128, qb ? 0 : 128, a.in[15] + j * 12 + 3 * kvh);
        } else { const int uu = u - n_swa, qb = uu % 16, h = (uu / 16) % 4, b = uu / 64; const size_t r1 = (size_t)b * SEQ + 128 * qb;
            const bf16* kb = MKB + (size_t)(b * 256) * 1024 + h * 128;
            attn_unit(F.lds, F.tid, QB + r1 * pitch + qoff + h * 128, pitch, 1, kb, kb + (size_t)128 * 1024, kb + 512, kb + 512 + (size_t)128 * 1024, 1024,
                      OCAT + r1 * D + 1536 + h * 128, D, -1024, 1024, 0, nullptr);
        }
    }
    __syncthreads();
}
template <int NH, int NKW, bool EXTRA>
__device__ __forceinline__ void decode_unit(LAS unsigned char* lds, int tid, const float* qp, const float* kc, const float* vc, const float* kx, const float* vx, const float* sinks,
                                            bf16* op, float* kout, float* vout) {
    const int lane = tid & 63, w = __builtin_amdgcn_readfirstlane(tid >> 6);
    LAS float* pm = (LAS float*)lds; LAS float* pa = pm + 64;
    f32x2_t q[NH], kr[NKW], vr[NKW], kxr = {0.f, 0.f}, vxr = {0.f, 0.f};
#pragma unroll
    for (int h = 0; h < NH; ++h) q[h] = *(const f32x2_t*)(qp + 128 * h);
#pragma unroll
    for (int i = 0; i < NKW; ++i) { const size_t j = (size_t)(w * NKW + i) * 512; kr[i] = *(const f32x2_t*)(kc + j); vr[i] = *(const f32x2_t*)(vc + j); }
    const bool ext = EXTRA && w == 7;
    if (ext) { kxr = *(const f32x2_t*)kx; vxr = *(const f32x2_t*)vx; }
    if (kout) {
#pragma unroll
        for (int i = 0; i < NKW; ++i) { const int j = w * NKW + i; if (j >= 1) { *(f32x2_t*)(kout + (size_t)(j - 1) * 512) = kr[i]; *(f32x2_t*)(vout + (size_t)(j - 1) * 512) = vr[i]; } }
        if (ext) { *(f32x2_t*)(kout + (size_t)(8 * NKW - 1) * 512) = kxr; *(f32x2_t*)(vout + (size_t)(8 * NKW - 1) * 512) = vxr; }
    }
    __syncthreads();
#pragma unroll
    for (int h = 0; h < NH; ++h) {
        float s[NKW], m = -1e30f, sx = -1e30f;
#pragma unroll
        for (int i = 0; i < NKW; ++i) { s[i] = wave_sum(q[h].x * kr[i].x + q[h].y * kr[i].y) * QSCALE; m = fmaxf(m, s[i]); }
        if (ext) { sx = wave_sum(q[h].x * kxr.x + q[h].y * kxr.y) * QSCALE; m = fmaxf(m, sx); }
        float l = 0.f; f32x2_t acc = {0.f, 0.f};
#pragma unroll
        for (int i = 0; i < NKW; ++i) { const float pp = __expf(s[i] - m); l += pp; acc += vr[i] * pp; }
        if (ext) { const float pp = __expf(sx - m); l += pp; acc += vxr * pp; }
        if (lane == 0) { pm[(w * NH + h) * 2] = m; pm[(w * NH + h) * 2 + 1] = l; }
        *(LAS f32x2_t*)(pa + (w * NH + h) * 128 + 2 * lane) = acc;
    }
    __syncthreads();
    if (w < NH) { const int h = w; const float sk = sinks ? sinks[h] : -1e30f; float M = sk;
#pragma unroll
        for (int ww = 0; ww < 8; ++ww) M = fmaxf(M, pm[(ww * NH + h) * 2]);
        float den = sinks ? __expf(sk - M) : 0.f; f32x2_t o = {0.f, 0.f};
#pragma unroll
        for (int ww = 0; ww < 8; ++ww) { const float f = __expf(pm[(ww * NH + h) * 2] - M); den += f * pm[(ww * NH + h) * 2 + 1]; o += *(const LAS f32x2_t*)(pa + (ww * NH + h) * 128 + 2 * lane) * f; }
        const float id = 1.0f / den; *(unsigned*)(op + 128 * h) = pk2(o.x * id, o.y * id); }
    __syncthreads();
}
__device__ __forceinline__ void ph_attn_sample(const Frame& F, const Args& a, int L, bool is_swa, int tf) {
    const int lane = F.lane, j = L / 2;
    const float* QKV = (const float*)(a.ws + WS_QKV); bf16* OCAT = (bf16*)(a.ws + WS_OCAT);
    const int pitch = is_swa ? SWA_IN : RET_IN, qoff = is_swa ? 2560 : 4608;
    const float* CMK = a.in[5] + (size_t)L * SB * 256 * 512; const float* CMV = a.in[6] + (size_t)L * SB * 256 * 512;
    const float* CK = a.in[2] + (size_t)j * SB * 128 * 512; const float* CV = a.in[3] + (size_t)j * SB * 128 * 512;
    const int n2 = is_swa ? SB * 4 : 0, n3 = n2 + SB * 4;
    for (int u = F.bid - tf; u < n3; u += F.G - tf) {
        if (u < n2) { const int kvh = u % 4, b = u / 4; const size_t row = (size_t)MP + b, co = ((size_t)b * 128) * 512 + kvh * 128 + 2 * lane;
            const float* kx = QKV + row * SWA_IN + 1536 + kvh * 128 + 2 * lane;
            decode_unit<3, 16, true>(F.lds, F.tid, QKV + row * SWA_IN + 3 * kvh * 128 + 2 * lane, CK + co, CV + co, kx, kx + 512, a.in[15] + j * 12 + 3 * kvh, OCAT + row * D + 3 * kvh * 128 + 2 * lane,
                                     a.out + O_SKS + (size_t)j * SB * 128 * 512 + co, a.out + O_SVS + (size_t)j * SB * 128 * 512 + co);
        } else { const int uu = u - n2, h = uu % 4, b = uu / 4; const size_t row = (size_t)MP + b, co = ((size_t)b * 256) * 512 + h * 128 + 2 * lane;
            decode_unit<1, 32, false>(F.lds, F.tid, QKV + row * pitch + qoff + h * 128 + 2 * lane, CMK + co, CMV + co, nullptr, nullptr, nullptr, OCAT + row * D + 1536 + h * 128 + 2 * lane, nullptr, nullptr);
        }
    }
}
__device__ __forceinline__ void ph_ret_r1(const Frame& F, const Args& a) {
    const bf16* QB = (const bf16*)(a.ws + WS_QKVB); float* DST = (float*)(a.ws + WS_DST);
    const int tid = F.tid, lane = F.lane, w = F.wave, r16 = lane & 15, g = lane >> 4, tq = r16 >> 2, tp = r16 & 3;
    LAS unsigned char* Kt = F.lds; LAS unsigned char* Vt = F.lds + 128 * KP;
    const bool bal = F.G == 256 && NB * 6 * 16 * 2 == 768;
    const int u2_0 = bal ? (F.bid < 128 ? F.bid : F.bid + 128) : F.bid, u2_s = bal ? 128 : F.G, u2_e = bal ? (F.bid < 128 ? 256 : 768) : NB * 6 * 16 * 2;
    for (int u2 = u2_0; u2 < u2_e; u2 += u2_s) {
        const int hf = u2 & 1, u = u2 >> 1, c = u % 16, h = (u / 16) % 6, b = u / 96; const size_t row0 = (size_t)b * SEQ + 128 * c;
        const float lg = log2f(1.0f - exp2f(-5.0f - (float)h));
        __syncthreads();
#pragma unroll
        for (int it = 0; it < 4; ++it) { const int row = it * 32 + (tid >> 4), ch = tid & 15;
            const v4u kv = *(const v4u*)(QB + (row0 + row) * RET_IN + 768 + h * 128 + ch * 8);
            const float f = exp2f((float)(127 - row) * lg);
            v4u o; o.x = pk2(bf2f(kv.x & 0xffff) * f, bf2f(kv.x >> 16) * f); o.y = pk2(bf2f(kv.y & 0xffff) * f, bf2f(kv.y >> 16) * f);
            o.z = pk2(bf2f(kv.z & 0xffff) * f, bf2f(kv.z >> 16) * f); o.w = pk2(bf2f(kv.w & 0xffff) * f, bf2f(kv.w >> 16) * f);
            *(LAS v4u*)(Kt + row * KP + ch * 16) = o;
            *(LAS v4u*)(Vt + row * KP + ch * 16) = *(const v4u*)(QB + (row0 + row) * RET_IN + 1536 + h * 256 + 128 * hf + ch * 8); }
        __syncthreads();
        f32x4 acc[8];
#pragma unroll
        for (int nt = 0; nt < 8; ++nt) acc[nt] = (f32x4){0.f, 0.f, 0.f, 0.f};
#pragma unroll
        for (int ks = 0; ks < 4; ++ks) {
            const bf16x8 af = frag_tr(Vt, 32 * ks + 8 * g, 32 * ks + 8 * g + 4, 16 * w, KP, tq, tp);
#pragma unroll
            for (int nt = 0; nt < 8; ++nt) { const bf16x8 bfr = frag_tr(Kt, 32 * ks + 8 * g, 32 * ks + 8 * g + 4, 16 * nt, KP, tq, tp); acc[nt] = MFMA16(af, bfr, acc[nt]); } }
        float* dp = DST + (size_t)u * 32768 + (size_t)(128 * hf + 16 * w + 4 * g) * 128 + r16;
#pragma unroll
        for (int nt = 0; nt < 8; ++nt)
#pragma unroll
            for (int r = 0; r < 4; ++r) dp[(size_t)r * 128 + 16 * nt] = acc[nt][r];
    }
    __syncthreads();
}
__device__ __forceinline__ void ph_ret_r2(const Frame& F, const Args& a, int jr) {
    const float* DST = (const float*)(a.ws + WS_DST); bf16* SC = (bf16*)(a.ws + WS_SC); float* so = a.out + O_RSP + (size_t)jr * NB * 6 * 32768;
    LAS float* tl = (LAS float*)(F.lds + RING_OFF);
    const int tid = F.tid, ntile = NB * 6 * 16;
    for (int t = F.bid; t < ntile; t += F.G) {
        const int bh = t >> 4, dv0 = (t & 15) * 16, h = bh % 6, e = dv0 * 128 + 4 * tid;
        const float cdec = exp2f(128.0f * log2f(1.0f - exp2f(-5.0f - (float)h)));
        f32x4 d[16];
#pragma unroll
        for (int c = 0; c < 16; ++c) d[c] = *(const f32x4*)(DST + ((size_t)bh * 16 + c) * 32768 + e);
        f32x4 S = {0.f, 0.f, 0.f, 0.f};
#pragma unroll
        for (int c = 0; c < 16; ++c) { uint2 o; o.x = pk2(S[0], S[1]); o.y = pk2(S[2], S[3]); *(uint2*)(SC + ((size_t)bh * 16 + c) * 32768 + e) = o; S = S * cdec + d[c]; }
        __syncthreads();
        { const int dvl = tid >> 5, dk = (tid & 31) * 4; LAS float* w = tl + dvl * 129 + dk; w[0] = S[0]; w[1] = S[1]; w[2] = S[2]; w[3] = S[3]; }
        __syncthreads();
#pragma unroll
        for (int k = 0; k < 4; ++k) { const int idx = tid + 512 * k, dk = idx >> 4, dvl = idx & 15; so[(size_t)bh * 32768 + (size_t)dk * 256 + dv0 + dvl] = tl[dvl * 129 + dk]; }
    }
    __syncthreads();
}
__device__ __forceinline__ void ph_ret_r3(const Frame& F, const Args& a) {
    const bf16* QB = (const bf16*)(a.ws + WS_QKVB); const bf16* SC = (const bf16*)(a.ws + WS_SC); bf16* OCAT = (bf16*)(a.ws + WS_OCAT);
    const int tid = F.tid, lane = F.lane, w = F.wave, r16 = lane & 15, g = lane >> 4, tq = r16 >> 2, tp = r16 & 3;
    LAS unsigned char* Kt = F.lds; LAS unsigned char* St = F.lds + 128 * KP; LAS unsigned char* Vt = F.lds + 128 * KP;
    for (int u = F.bid; u < NB * 6 * 16; u += F.G) {
        const int c = u % 16, h = (u / 16) % 6, b = u / 96; const size_t row0 = (size_t)b * SEQ + 128 * c;
        const float lg = log2f(1.0f - exp2f(-5.0f - (float)h));
        __syncthreads();
#pragma unroll
        for (int it = 0; it < 4; ++it) { const int row = it * 32 + (tid >> 4), ch = tid & 15;
            *(LAS v4u*)(Kt + row * KP + ch * 16) = *(const v4u*)(QB + (row0 + row) * RET_IN + 768 + h * 128 + ch * 8); }
#pragma unroll
        for (int it = 0; it < 8; ++it) { const int row = it * 32 + (tid >> 4), ch = tid & 15;
            *(LAS v4u*)(St + row * KP + ch * 16) = *(const v4u*)(SC + (size_t)u * 32768 + (size_t)row * 128 + ch * 8); }
        __syncthreads();
        const int ti = 16 * w + r16;
        const bf16* qp = QB + (row0 + ti) * RET_IN + h * 128 + 8 * g;
        bf16x8 qf[4];
#pragma unroll
        for (int ks = 0; ks < 4; ++ks) qf[ks] = *(const bf16x8*)(qp + 32 * ks);
        f32x4 s[8];
#pragma unroll
        for (int nt = 0; nt < 8; ++nt) { s[nt] = (f32x4){0.f, 0.f, 0.f, 0.f};
            if (nt <= w) {
#pragma unroll
                for (int ks = 0; ks < 4; ++ks) { const bf16x8 kf = *(const LAS bf16x8*)(Kt + (16 * nt + r16) * KP + (32 * ks + 8 * g) * 2); s[nt] = MFMA16(kf, qf[ks], s[nt]); }
#pragma unroll
                for (int r = 0; r < 4; ++r) { const int sk = 16 * nt + 4 * g + r; s[nt][r] = (sk <= ti) ? s[nt][r] * exp2f(-(float)(sk + 1) * lg) : 0.f; } } }
        f32x4 acc[16];
#pragma unroll
        for (int mt = 0; mt < 16; ++mt) { acc[mt] = (f32x4){0.f, 0.f, 0.f, 0.f};
#pragma unroll
            for (int ks = 0; ks < 4; ++ks) { const bf16x8 sf = *(const LAS bf16x8*)(St + (16 * mt + r16) * KP + (32 * ks + 8 * g) * 2); acc[mt] = MFMA16(sf, qf[ks], acc[mt]); } }
        __syncthreads();
#pragma unroll
        for (int it = 0; it < 8; ++it) { const int row = it * 16 + (tid >> 5), ch = tid & 31;
            *(LAS v4u*)(Vt + row * VP2 + ch * 16) = *(const v4u*)(QB + (row0 + row) * RET_IN + 1536 + h * 256 + ch * 8); }
        __syncthreads();
#pragma unroll
        for (int ks = 0; ks < 4; ++ks) {
            if (2 * ks <= w) {
                const bf16x8 pf = pack_bf8(s[2 * ks], s[2 * ks + 1]);
#pragma unroll
                for (int mt = 0; mt < 16; ++mt) { const bf16x8 vf = frag_tr(Vt, 32 * ks + 4 * g, 32 * ks + 16 + 4 * g, 16 * mt, VP2, tq, tp); acc[mt] = MFMA16(vf, pf, acc[mt]); } } }
        const float qd = exp2f((float)(ti + 1) * lg); float sum = 0.f;
#pragma unroll
        for (int mt = 0; mt < 16; ++mt) { acc[mt] = acc[mt] * qd; sum += (acc[mt][0] + acc[mt][1]) + (acc[mt][2] + acc[mt][3]); }
        sum += __shfl_xor(sum, 16); sum += __shfl_xor(sum, 32);
        const float mean = sum * (1.f / 256.f); float sq = 0.f;
#pragma unroll
        for (int mt = 0; mt < 16; ++mt) { acc[mt] = acc[mt] - mean; sq += (acc[mt][0] * acc[mt][0] + acc[mt][1] * acc[mt][1]) + (acc[mt][2] * acc[mt][2] + acc[mt][3] * acc[mt][3]); }
        sq += __shfl_xor(sq, 16); sq += __shfl_xor(sq, 32);
        const float rstd = 1.0f / sqrtf(sq * (1.f / 256.f) + HN_EPS);
        const bf16* gp = QB + (row0 + ti) * RET_IN + 3072 + h * 256 + 4 * g; bf16* op = OCAT + (row0 + ti) * D + h * 256 + 4 * g;
        uint2 gate[16];
#pragma unroll
        for (int mt = 0; mt < 16; ++mt) gate[mt] = *(const uint2*)(gp + 16 * mt);
#pragma unroll
        for (int mt = 0; mt < 16; ++mt) { const uint2 gg = gate[mt];
            uint2 o; o.x = pk2(silu_f(bf2f(gg.x & 0xffff)) * acc[mt][0] * rstd, silu_f(bf2f(gg.x >> 16)) * acc[mt][1] * rstd);
            o.y = pk2(silu_f(bf2f(gg.y & 0xffff)) * acc[mt][2] * rstd, silu_f(bf2f(gg.y >> 16)) * acc[mt][3] * rstd);
            *(uint2*)(op + 16 * mt) = o; }
    }
    __syncthreads();
}
__device__ __forceinline__ void ph_ret_sample(const Frame& F, const Args& a, int jr) {
    const float* QKV = (const float*)(a.ws + WS_QKV); float* ORAW = (float*)(a.ws + WS_ORAW);
    LAS float* qs = (LAS float*)(F.lds + RING_OFF); LAS float* ks = qs + 128; LAS float* po = qs + 256;
    const int dv = F.tid & 255, hf = F.tid >> 8;
    for (int u = F.G - 1 - F.bid; u < SB * 6; u += F.G) {
        const int seq = u / 6, h = u % 6; const size_t row = (size_t)MP + seq;
        const float* S0 = a.in[4] + (size_t)jr * SB * 6 * 32768; float* Sout = a.out + O_RSS + (size_t)jr * SB * 6 * 32768;
        const float gamma = 1.0f - exp2f(-5.0f - (float)h);
        const size_t so = (size_t)(seq * 6 + h) * 32768 + (size_t)(64 * hf) * 256 + dv;
        const float* p = QKV + row * RET_IN;
        __syncthreads();
        if (F.tid < 128) qs[F.tid] = p[h * 128 + F.tid]; else if (F.tid < 256) ks[F.tid - 128] = p[768 + h * 128 + (F.tid - 128)];
        const float v = p[1536 + h * 256 + dv];
        __syncthreads();
        float o = 0.f;
#pragma unroll
        for (int i0 = 0; i0 < 64; i0 += 32) {
            float s0[32];
#pragma unroll
            for (int j = 0; j < 32; ++j) s0[j] = S0[so + (size_t)(i0 + j) * 256];
#pragma unroll
            for (int j = 0; j < 32; ++j) { const int i = 64 * hf + i0 + j; const float sn = gamma * s0[j] + ks[i] * v; Sout[so + (size_t)(i0 + j) * 256] = sn; o += qs[i] * sn; }
        }
        if (hf) po[dv] = o;
        __syncthreads();
        if (!hf) ORAW[row * 1536 + h * 256 + dv] = o + po[dv];
    }
    __syncthreads();
}

#ifndef WBITS
#define WBITS 5
#endif
__device__ __forceinline__ unsigned f2bfw(float f) { constexpr unsigned sh = 23 - WBITS; unsigned u = __builtin_bit_cast(unsigned, f); u += ((1u << (sh - 1)) - 1u) + ((u >> sh) & 1u); return (u >> sh) << (sh - 16); }
__device__ __forceinline__ unsigned pkw(float lo, float hi) { return f2bfw(lo) | (f2bfw(hi) << 16); }
__device__ __forceinline__ void conv_load(float (&r)[64], const float* wu, int pitch, int lane) {
#pragma unroll
    for (int kk = 0; kk < 64; ++kk) r[kk] = __builtin_nontemporal_load((wu + (size_t)kk * pitch) + lane);
}
__device__ __forceinline__ void conv_proc(const float (&r)[64], LAS float* scr, int lane, bf16* wt, int K, const float* gain, const float* bias, float (&c1)[8], float& c2, bool coarse) {
#pragma unroll
    for (int kk = 0; kk < 64; ++kk) { float gk = 1.f; if (gain) { gk = gain[kk]; c2 += bias[kk] * r[kk]; } scr[kk * 65 + lane] = r[kk] * gk; }
    LDS_WAIT();
    const int c = lane & 7;
#pragma unroll
    for (int j = 0; j < 8; ++j) { const int n = (lane >> 3) + 8 * j; const LAS float* s = scr + (8 * c) * 65 + n;
        v4u o; if (coarse) { o.x = pkw(s[0 * 65], s[1 * 65]); o.y = pkw(s[2 * 65], s[3 * 65]); o.z = pkw(s[4 * 65], s[5 * 65]); o.w = pkw(s[6 * 65], s[7 * 65]); }
        else { o.x = pk2(s[0 * 65], s[1 * 65]); o.y = pk2(s[2 * 65], s[3 * 65]); o.z = pk2(s[4 * 65], s[5 * 65]); o.w = pk2(s[6 * 65], s[7 * 65]); }
        *(v4u*)(wt + (size_t)n * K + 8 * c) = o;
#pragma unroll
        for (int q = 0; q < 4; ++q) c1[j] += bf2f(o[q] & 0xffffu) + bf2f(o[q] >> 16); }
    LDS_WAIT();
}
__device__ __forceinline__ void conv_item(LAS float* scr, int lane, const float* W, int K, int pitch, int col0, bf16* WT, int row0, int kb0, int nkb, const float* gain, const float* bias, float* c1p, float* c2p, bool coarse) {
    float c1[8] = {0.f, 0.f, 0.f, 0.f, 0.f, 0.f, 0.f, 0.f}, c2 = 0.f;
    const float* wp = W + (size_t)(64 * kb0) * pitch + col0; bf16* wt = WT + (size_t)row0 * K + 64 * kb0;
    const float* gp = gain ? gain + 64 * kb0 : nullptr; const float* bp = gain ? bias + 64 * kb0 : nullptr;
    float ra[64], rb[64];
    conv_load(ra, wp, pitch, lane);
    for (int i = 0; i < nkb; i += 2) {
        const bool h1 = i + 1 < nkb, h2 = i + 2 < nkb;
        if (h1) conv_load(rb, wp + (size_t)64 * (i + 1) * pitch, pitch, lane);
        conv_proc(ra, scr, lane, wt + 64 * i, K, gp ? gp + 64 * i : nullptr, gp ? bp + 64 * i : nullptr, c1, c2, coarse);
        if (h1) { if (h2) conv_load(ra, wp + (size_t)64 * (i + 2) * pitch, pitch, lane);
            conv_proc(rb, scr, lane, wt + 64 * (i + 1), K, gp ? gp + 64 * (i + 1) : nullptr, gp ? bp + 64 * (i + 1) : nullptr, c1, c2, coarse); }
    }
    if (c1p) {
#pragma unroll
        for (int j = 0; j < 8; ++j) { float t = c1[j]; t += __shfl_xor(t, 1); t += __shfl_xor(t, 2); t += __shfl_xor(t, 4); c1[j] = t; }
        if ((lane & 7) == 0) {
#pragma unroll
            for (int j = 0; j < 8; ++j) c1p[(lane >> 3) + 8 * j] = c1[j]; }
        c2p[lane] = c2;
    }
}
__device__ __forceinline__ void ph_prologue(const Frame& F, const Args& a) {
    unsigned char* ws = a.ws; const int lane = F.lane;
    LAS float* scr = (LAS float*)(F.lds + RING_OFF + F.wave * 16640);
    constexpr int NB_GU = NGU / 64, NB_INS = SWA_IN / 64, NB_INR = RET_IN / 64;
    constexpr int N_BIG = 8 * NB_GU + 2 * NB_INS + 2 * NB_INR;
    constexpr int I_OUT = 4 * (D / 64) * 2, I_MEM = 4 * (1024 / 64) * 2, I_DN = 8 * (D / 64) * 32;
    constexpr int N_ALL = N_BIG + I_OUT + I_MEM + I_DN;
    bf16* Z0 = zbuf(ws, 0);
    for (size_t i = F.gtid; i < (size_t)MP * D / 4; i += F.ngt) { const float4 v = ((const float4*)a.in[0])[i]; uint2 o; o.x = pk2(v.x, v.y); o.y = pk2(v.z, v.w); ((uint2*)Z0)[i] = o; }
    for (size_t i = F.gtid; i < (size_t)SB * D / 4; i += F.ngt) { const float4 v = ((const float4*)a.in[1])[i]; uint2 o; o.x = pk2(v.x, v.y); o.y = pk2(v.z, v.w); ((uint2*)(Z0 + (size_t)MP * D))[i] = o; }
    for (size_t i = F.gtid; i < (size_t)1024 * D / 4; i += F.ngt) { const float4 v = ((const float4*)a.in[7])[i]; uint2 o; o.x = pk2(v.x, v.y); o.y = pk2(v.z, v.w); ((uint2*)(ws + WS_XMEMB))[i] = o; }
    { long long* st0 = stbuf(ws, 0); for (size_t i = F.gtid; i < (size_t)MP; i += F.ngt) { st0[2 * i] = 0; st0[2 * i + 1] = __float2ll_rn((float)D * (1.0f - LN_EPS) * ST_SCALE); }
      float* on = (float*)(ws + WS_ONES); for (size_t i = F.gtid; i < (size_t)2 * D; i += F.ngt) on[i] = i < (size_t)D ? 1.f : 0.f; }
    { float* rp = (float*)(ws + WS_ROPE);
      for (size_t i = F.gtid; i < (size_t)SEQ * 16; i += F.ngt) { const int pos = (int)(i >> 4), ii = (int)(i & 15); const float inv = powf(500000.0f, -(float)ii / 16.0f), ang = (float)pos * inv;
          float sn, cs; sincosf(ang, &sn, &cs); rp[2 * i] = cs; rp[2 * i + 1] = sn; }
      float* rr = (float*)(ws + WS_RETCS);
      for (size_t i = F.gtid; i < (size_t)SEQ * 64; i += F.ngt) { const int pos = (int)(i >> 6), ii = (int)(i & 63); const float an = powf(10000.0f, -((float)ii / 63.0f)), ang = (float)pos * an;
          float sn, cs; sincosf(ang, &sn, &cs); rr[2 * i] = cs; rr[2 * i + 1] = sn; } }
    unsigned* qword = (unsigned*)(ws + WS_CTL) + CW_Q;
    volatile LAS unsigned* tk = (volatile LAS unsigned*)(F.lds + LDSCTL_OFF + 64);
    for (;;) {
        __syncthreads();
        if (F.tid == 0) *tk = atomicAdd(qword, 8u);
        __syncthreads();
        const unsigned qb = *tk; if (qb >= (unsigned)N_ALL) break;
        const unsigned q = qb + (unsigned)F.wave; if (q >= (unsigned)N_ALL) continue;
        int r = (int)q;
        const float* W; int K = D, pitch, col0, row0, kb0 = 0, nkb = D / 64, v = 0; bf16* WT; float* c1p = nullptr; float* c2p = nullptr; bool coarse = true;
        if (r < N_BIG) {
            if (r < 8 * NB_GU) { const int m = r / NB_GU, nb = r % NB_GU, L = m >> 1, s = m & 1; v = 3 * L + (s ? 2 : 0);
                W = a.in[10] + (size_t)m * D * NGU; pitch = NGU; WT = (bf16*)(ws + WS_WGU) + (size_t)m * NGU * D; row0 = 64 * nb;
                const int pn = row0 >> 8, o = row0 & 255; col0 = o < 128 ? 128 * pn + o : DFF + 128 * pn + (o - 128);
                c1p = (float*)(ws + WS_C1GU) + (size_t)m * NGU + row0; c2p = c1p + (size_t)8 * NGU; }
            else if ((r -= 8 * NB_GU) < 2 * NB_INS) { const int m = r / NB_INS, nb = r % NB_INS; v = 3 * (2 * m) + 1; coarse = false;
                W = a.in[13] + (size_t)m * D * SWA_IN; pitch = SWA_IN; WT = (bf16*)(ws + WS_WINS) + (size_t)m * SWA_IN * D; row0 = 64 * nb; col0 = row0;
                c1p = (float*)(ws + WS_C1INS) + (size_t)m * SWA_IN + row0; c2p = c1p + (size_t)2 * SWA_IN; }
            else { r -= 2 * NB_INS; const int m = r / NB_INR, nb = r % NB_INR; v = 3 * (2 * m + 1) + 1; coarse = false;
                W = a.in[16] + (size_t)m * D * RET_IN; pitch = RET_IN; WT = (bf16*)(ws + WS_WINR) + (size_t)m * RET_IN * D; row0 = 64 * nb; col0 = row0;
                c1p = (float*)(ws + WS_C1INR) + (size_t)m * RET_IN + row0; c2p = c1p + (size_t)2 * RET_IN; }
        } else if ((r -= N_BIG) < I_OUT) { const int nb = r % (D / 64), kr = (r / (D / 64)) & 1, m = r / (2 * (D / 64));
            W = ((m & 1) ? a.in[17] : a.in[14]) + (size_t)(m >> 1) * D * D; pitch = D; WT = (bf16*)(ws + WS_WOUT) + (size_t)m * D * D; row0 = col0 = 64 * nb; kb0 = 16 * kr; nkb = 16;
        } else if ((r -= I_OUT) < I_MEM) { const int nb = r % (1024 / 64), kr = (r / (1024 / 64)) & 1, m = r / (2 * (1024 / 64)); coarse = false;
            W = a.in[12] + (size_t)m * D * 1024; pitch = 1024; WT = (bf16*)(ws + WS_WMEM) + (size_t)m * 1024 * D; row0 = col0 = 64 * nb; kb0 = 16 * kr; nkb = 16;
        } else { r -= I_MEM; const int nb = r % (D / 64), kr = (r / (D / 64)) & 31, m = r / (32 * (D / 64));
            W = a.in[11] + (size_t)m * DFF * D; K = DFF; pitch = D; WT = (bf16*)(ws + WS_WDN) + (size_t)m * D * DFF; row0 = col0 = 64 * nb; kb0 = kr < 24 ? 3 * kr : 72 + 2 * (kr - 24); nkb = kr < 24 ? 3 : 2;
        }
        conv_item(scr, lane, W, K, pitch, col0, WT, row0, kb0, nkb, v ? lngain(a, v) : nullptr, v ? lnbias(a, v) : nullptr, c1p, c2p, coarse);
    }
}

__device__ __forceinline__ void sample_stats(const Frame& F, const bf16* Zs, bool identity) {
    LAS f32x2_t* sst = (LAS f32x2_t*)(F.lds + SSTAT_OFF);
    const int row = F.tid >> 4, sub = F.tid & 15; float sum = 0.f, sq = 0.f;
#pragma unroll 4
    for (int i = 0; i < 16; ++i) { const v4u z = *(const v4u*)(Zs + (size_t)row * D + 8 * (sub + 16 * i));
#pragma unroll
        for (int q = 0; q < 4; ++q) { const float lo = bf2f(z[q] & 0xffffu), hi = bf2f(z[q] >> 16); sum += lo + hi; sq += lo * lo + hi * hi; } }
#pragma unroll
    for (int o = 1; o < 16; o <<= 1) { sum += __shfl_xor(sum, o); sq += __shfl_xor(sq, o); }
    const float mu = sum * (1.f / D), var = sq * (1.f / D) - mu * mu;
    __syncthreads();
    if (sub == 0) sst[row] = identity ? (f32x2_t){0.f, 1.f} : (f32x2_t){mu, 1.0f / sqrtf(fmaxf(var, 0.f) + LN_EPS)};
    __syncthreads();
}
struct SEpi { const float* c1; const float* c2; bf16* H; const bf16* Zo; bf16* Zn; const float* g; const float* b; float* QS; float s; int pad; };
template <int KIND> __device__ __forceinline__ void ph_sgemm(const Frame& F, const bf16* A, const bf16* Bt, int N, int K, const SEpi& E, int tf) {
    const int tid = F.tid, lane = F.lane, w = F.wave, r16 = lane & 15, g = lane >> 4;
    LAS float* red = (LAS float*)F.lds;
    const LAS f32x2_t* sst = (const LAS f32x2_t*)(F.lds + SSTAT_OFF);
    const int nitems = N / 32, kw = K / 8;
    for (int it = F.bid - tf; it < nitems; it += F.G - tf) {
        if (it < 0) break;
        int r0, r1; if (KIND == 0) { r0 = 256 * (it >> 3) + 16 * (it & 7); r1 = r0 + 128; } else { r0 = 32 * it; r1 = r0 + 16; }
        f32x4 acc[2][2];
#pragma unroll
        for (int m = 0; m < 2; ++m)
#pragma unroll
            for (int t = 0; t < 2; ++t) acc[m][t] = (f32x4){0.f, 0.f, 0.f, 0.f};
        const bf16* ap = A + (size_t)r16 * K + w * kw + 16 * g;
        const bf16* bp0 = Bt + (size_t)(r0 + r16) * K + w * kw + 16 * g; const bf16* bp1 = Bt + (size_t)(r1 + r16) * K + w * kw + 16 * g;
#pragma unroll 4
        for (int kc = 0; kc < kw; kc += 64) {
            bf16x8 af[2][2], bfr[2][2];
#pragma unroll
            for (int s2 = 0; s2 < 2; ++s2) { af[0][s2] = *(const bf16x8*)(ap + kc + 8 * s2); af[1][s2] = *(const bf16x8*)(ap + (size_t)16 * K + kc + 8 * s2);
                bfr[0][s2] = *(const bf16x8*)(bp0 + kc + 8 * s2); bfr[1][s2] = *(const bf16x8*)(bp1 + kc + 8 * s2); }
#pragma unroll
            for (int s2 = 0; s2 < 2; ++s2)
#pragma unroll
                for (int m = 0; m < 2; ++m)
#pragma unroll
                    for (int t = 0; t < 2; ++t) acc[m][t] = MFMA16(af[m][s2], bfr[t][s2], acc[m][t]);
        }
        __syncthreads();
#pragma unroll
        for (int m = 0; m < 2; ++m)
#pragma unroll
            for (int t = 0; t < 2; ++t)
#pragma unroll
                for (int r = 0; r < 4; ++r) red[(w * 32 + 16 * m + 4 * g + r) * 32 + 16 * t + r16] = acc[m][t][r];
        __syncthreads();
        const int row = tid >> 4, cp = tid & 15; float v0 = 0.f, v1 = 0.f;
#pragma unroll
        for (int ww = 0; ww < 8; ++ww) { v0 += red[(ww * 32 + row) * 32 + cp]; v1 += red[(ww * 32 + row) * 32 + 16 + cp]; }
        const f32x2_t st = sst[row];
        if (KIND == 0) {
            const float gg = st.y * (v0 - st.x * E.c1[r0 + cp]) + E.c2[r0 + cp], uu = st.y * (v1 - st.x * E.c1[r1 + cp]) + E.c2[r1 + cp];
            E.H[(size_t)row * DFF + 128 * (it >> 3) + 16 * (it & 7) + cp] = (bf16)f2bf(silu_f(gg) * uu);
        } else if (KIND == 1) {
#pragma unroll
            for (int t = 0; t < 2; ++t) { const int col = r0 + 16 * t + cp; const float zo = bf2f(E.Zo[(size_t)row * D + col]);
                E.Zn[(size_t)row * D + col] = (bf16)f2bf(ALPHA * ((zo - st.x) * st.y * E.g[col] + E.b[col]) + E.s * (t ? v1 : v0)); }
        } else {
            constexpr int N_ = KIND == 2 ? SWA_IN : RET_IN;
            float x0 = st.y * (v0 - st.x * E.c1[r0 + cp]) + E.c2[r0 + cp], x1 = st.y * (v1 - st.x * E.c1[r1 + cp]) + E.c2[r1 + cp];
            if (KIND == 2) {
                if (r0 < 2048 && (r0 & 127) == 0) {
                    const float inv = powf(500000.0f, -(float)cp / 16.0f); float sn, cs; sincosf((float)PAST * inv, &sn, &cs);
                    const float a0 = x0 * cs - x1 * sn, a1 = x1 * cs + x0 * sn; x0 = a0; x1 = a1; }
            } else {
                if (r0 < 1536) {
                    const float sc = r0 < 768 ? 1.0f : QSCALE;
#pragma unroll
                    for (int t = 0; t < 2; ++t) { float& x = t ? x1 : x0; const int col = r0 + 16 * t + cp; const float an = powf(10000.0f, -((float)((col & 127) >> 1) / 63.0f));
                        float sn, cs; sincosf((float)PAST * an, &sn, &cs); const float o = __shfl_xor(x, 1);
                        x = ((cp & 1) ? x * cs + o * sn : x * cs - o * sn) * sc; }
                }
            }
            E.QS[(size_t)row * N_ + r0 + cp] = x0; E.QS[(size_t)row * N_ + r1 + cp] = x1;
        }
    }
    __syncthreads();
}
__device__ __forceinline__ void ph_final(const Frame& F, const Args& a) {
    const bf16* Z = zbuf(a.ws, 12); const long long* st = stbuf(a.ws, 12); const float* g = lngain(a, 12); const float* b = lnbias(a, 12); const int lane = F.lane;
    f32x4 gv[4][2], bv[4][2];
#pragma unroll
    for (int j = 0; j < 4; ++j)
#pragma unroll
        for (int q = 0; q < 2; ++q) { gv[j][q] = *(const f32x4*)(g + 8 * (lane + 64 * j) + 4 * q); bv[j][q] = *(const f32x4*)(b + 8 * (lane + 64 * j) + 4 * q); }
    for (int r = F.gw; r < MR; r += F.ngw) {
        v4u z[4];
#pragma unroll
        for (int j = 0; j < 4; ++j) z[j] = *(const v4u*)(Z + (size_t)r * D + 8 * (lane + 64 * j));
        float mu, rs;
        if (r < MP) row_stats(st, r, mu, rs);
        else { float sum = 0.f, sq = 0.f;
#pragma unroll
            for (int j = 0; j < 4; ++j)
#pragma unroll
                for (int q = 0; q < 4; ++q) { const float lo = bf2f(z[j][q] & 0xffffu), hi = bf2f(z[j][q] >> 16); sum += lo + hi; sq += lo * lo + hi * hi; }
            sum = wave_sum(sum); sq = wave_sum(sq); mu = sum * (1.f / D); rs = 1.0f / sqrtf(fmaxf(sq * (1.f / D) - mu * mu, 0.f) + LN_EPS); }
#pragma unroll
        for (int j = 0; j < 4; ++j) { const int c = 8 * (lane + 64 * j); f32x4 o0, o1;
#pragma unroll
            for (int q = 0; q < 2; ++q) { o0[2 * q] = (bf2f(z[j][q] & 0xffffu) - mu) * rs * gv[j][0][2 * q] + bv[j][0][2 * q]; o0[2 * q + 1] = (bf2f(z[j][q] >> 16) - mu) * rs * gv[j][0][2 * q + 1] + bv[j][0][2 * q + 1];
                o1[2 * q] = (bf2f(z[j][2 + q] & 0xffffu) - mu) * rs * gv[j][1][2 * q] + bv[j][1][2 * q]; o1[2 * q + 1] = (bf2f(z[j][2 + q] >> 16) - mu) * rs * gv[j][1][2 * q + 1] + bv[j][1][2 * q + 1]; }
            float* op = a.out + O_YP + (size_t)r * D + c; *(f32x4*)op = o0; *(f32x4*)(op + 4) = o1; }
    }
}
__device__ __forceinline__ void ph_headnorm_gate(const Frame& F, const float* ORAW, const float* QKV, bf16* OCAT, int row_off, int rows) {
    const int lane = F.lane; const int nw = rows * 6;
    for (int w = F.gw; w < nw; w += F.ngw) {
        const int h = w % 6; const size_t row = (size_t)row_off + w / 6;
        const float4 o = *(const float4*)(ORAW + row * 1536 + h * 256 + 4 * lane);
        const float mean = wave_sum((o.x + o.y) + (o.z + o.w)) * (1.f / 256.f);
        const float dx = o.x - mean, dy = o.y - mean, dz = o.z - mean, dw = o.w - mean;
        const float rstd = 1.0f / sqrtf(wave_sum((dx * dx + dy * dy) + (dz * dz + dw * dw)) * (1.f / 256.f) + HN_EPS);
        const float4 g = *(const float4*)(QKV + row * RET_IN + 3072 + h * 256 + 4 * lane);
        uint2 p; p.x = pk2(silu_f(g.x) * dx * rstd, silu_f(g.y) * dy * rstd); p.y = pk2(silu_f(g.z) * dz * rstd, silu_f(g.w) * dw * rstd);
        *(uint2*)(OCAT + row * D + h * 256 + 4 * lane) = p;
    }
}

__device__ __forceinline__ Frame mkframe(LAS unsigned char* lds) {
    Frame F; int t = threadIdx.x; asm volatile("" : "+v"(t));
    F.lds = lds; F.tid = t; F.lane = t & 63; F.wave = __builtin_amdgcn_readfirstlane(t >> 6);
    F.G = gridDim.x; F.bid = blockIdx.x;
    F.gtid = (size_t)F.bid * NTHR + F.tid; F.ngt = (size_t)F.G * NTHR; F.gw = F.bid * NWAVES + F.wave; F.ngw = F.G * NWAVES;
    return F;
}
#define GRID_BAR() xcd_barrier(bar)
__device__ __forceinline__ void sub_barrier(unsigned* cnt, unsigned n) {
    asm volatile("s_waitcnt vmcnt(0)" ::: "memory");
    __syncthreads();
    if (threadIdx.x == 0) {
        __builtin_amdgcn_fence(__ATOMIC_RELEASE, "agent");
        asm volatile("s_waitcnt vmcnt(0)" ::: "memory");
        xb_add(cnt, 1u);
        unsigned sp = 0;
        while (xb_ld(cnt) < n) { __builtin_amdgcn_s_sleep(1); if (++sp > (1u << 22)) break; }
        __builtin_amdgcn_fence(__ATOMIC_ACQUIRE, "agent");
        asm volatile("s_waitcnt vmcnt(0)" ::: "memory");
    }
    __syncthreads();
}
template <class Epi> __device__ __forceinline__ void run_gemm(const Frame& F, const bf16* A, const bf16* Bt, int M, int N, int K, const Epi& E, int cshift) {
    pg8::Gemm g; g.A = A; g.Bt = Bt; g.M = M; g.N = N; g.K = K;
    pg8::StaticOrder S; S.init(M, N, F.G, (F.bid + cshift) % F.G);
    pg8::gemm_phase<Epi, pg8::StaticOrder, true, true>(F.lds + RING_OFF, g, S, E);
}
template <int S> __device__ __forceinline__ void ffn_step(const Args& a, LAS unsigned char* lds, const XcdBarrier& bar, int L, bool with_mem) {
    unsigned char* ws = a.ws; const Frame F = mkframe(lds);
    const int wi = 2 * L + S, v = 3 * L + (S ? 2 : 0);
    const bf16* Zc = zbuf(ws, v); bf16* Zn = zbuf(ws, v + 1); bf16* H = (bf16*)(ws + WS_H);
    const bf16* wgu = (const bf16*)(ws + WS_WGU) + (size_t)wi * NGU * D; const bf16* wdn = (const bf16*)(ws + WS_WDN) + (size_t)wi * D * DFF;
    const float* c1 = (const float*)(ws + WS_C1GU) + (size_t)wi * NGU; const float* c2 = c1 + (size_t)8 * NGU;
    { EpiGU E; E.H = H; E.st = stbuf(ws, v); E.c1 = c1; E.c2 = c2; run_gemm(F, Zc, wgu, MP, NGU, D, E, 0); }
    if (with_mem) { EpiMem E; E.out = a.out; E.MKB = (bf16*)(ws + WS_MEMKB); run_gemm(F, (const bf16*)(ws + WS_XMEMB), (const bf16*)(ws + WS_WMEM), 1024, 4096, D, E, F.G / 2); }
    const int tf = with_mem ? (3 * F.G) / 4 : F.G / 2;
    if (F.bid >= tf) { sample_stats(F, Zc + (size_t)MP * D, v == 0);
        { SEpi E{}; E.c1 = c1; E.c2 = c2; E.H = H + (size_t)MP * DFF; ph_sgemm<0>(F, Zc + (size_t)MP * D, wgu, NGU, D, E, tf); }
        sub_barrier((unsigned*)(ws + WS_CTL) + 1024 + 32 * wi, (unsigned)(F.G - tf));
        { SEpi E{}; E.Zo = Zc + (size_t)MP * D; E.Zn = Zn + (size_t)MP * D; E.g = lngain(a, v); E.b = lnbias(a, v); E.s = 0.5f; ph_sgemm<1>(F, H + (size_t)MP * DFF, wdn, D, DFF, E, tf); } }
    GRID_BAR();
    { EpiRes E; E.Zo = Zc; E.Zn = Zn; E.sto = stbuf(ws, v); E.stn = stbuf(ws, v + 1); E.g = lngain(a, v); E.b = lnbias(a, v); E.s = 0.5f; E.pad = 0; run_gemm(F, H, wdn, MP, D, DFF, E, 0); }
    GRID_BAR();
}
template <int L> __device__ __forceinline__ void layer(const Args& a, LAS unsigned char* lds, const XcdBarrier& bar) {
    constexpr int j = L / 2; constexpr bool is_swa = (L & 1) == 0; constexpr int nin = is_swa ? SWA_IN : RET_IN, v = 3 * L + 1;
    ffn_step<0>(a, lds, bar, L, L == 0);
    {
        unsigned char* ws = a.ws; const Frame F = mkframe(lds);
        const bf16* Zc = zbuf(ws, v); bf16* Zn = zbuf(ws, v + 1); float* QKV = (float*)(ws + WS_QKV); float* ORAW = (float*)(ws + WS_ORAW); bf16* OCAT = (bf16*)(ws + WS_OCAT);
        const bf16* win = is_swa ? (const bf16*)(ws + WS_WINS) + (size_t)j * SWA_IN * D : (const bf16*)(ws + WS_WINR) + (size_t)j * RET_IN * D;
        const float* c1 = is_swa ? (const float*)(ws + WS_C1INS) + (size_t)j * SWA_IN : (const float*)(ws + WS_C1INR) + (size_t)j * RET_IN; const float* c2 = c1 + 2 * nin;
        { EpiIn<is_swa ? 0 : 1> E; E.QB = (bf16*)(ws + WS_QKVB); E.st = stbuf(ws, v); E.c1 = c1; E.c2 = c2; E.rope = (const f32x4*)(ws + WS_ROPE); E.retcs = (const f32x4*)(ws + WS_RETCS); E.out = a.out; E.jl = j; E.pad = 0;
          run_gemm(F, Zc, win, MP, nin, D, E, 0); }
        if (F.bid >= F.G / 2) { sample_stats(F, Zc + (size_t)MP * D, false);
            { SEpi E{}; E.c1 = c1; E.c2 = c2; E.QS = QKV + (size_t)MP * nin; ph_sgemm<is_swa ? 2 : 3>(F, Zc + (size_t)MP * D, win, nin, D, E, F.G / 2); }
            if (is_swa) { sub_barrier((unsigned*)(ws + WS_CTL) + 1024 + 32 * (12 + L), (unsigned)(F.G - F.G / 2));
                ph_attn_sample(F, a, L, true, F.G / 2); } }
        GRID_BAR();
        if (is_swa) {
            ph_attn_mfma(F, a, L, true, 0);
        } else {
            ph_ret_r1(F, a);
            ph_attn_sample(F, a, L, false, 0);
            GRID_BAR();
            ph_ret_r2(F, a, j);
            ph_ret_sample(F, a, j);
            GRID_BAR();
            ph_ret_r3(F, a);
            ph_attn_mfma(F, a, L, false, F.G / 2);
            ph_headnorm_gate(F, ORAW, QKV, OCAT, MP, SB);
        }
        GRID_BAR();
        const bf16* wout = (const bf16*)(ws + WS_WOUT) + (size_t)L * D * D;
        if (F.bid < D / 32 || F.G < D / 32) { sample_stats(F, Zc + (size_t)MP * D, false);
            SEpi E{}; E.Zo = Zc + (size_t)MP * D; E.Zn = Zn + (size_t)MP * D; E.g = lngain(a, v); E.b = lnbias(a, v); E.s = 1.0f; ph_sgemm<1>(F, OCAT + (size_t)MP * D, wout, D, D, E, 0); }
        { EpiRes E; E.Zo = Zc; E.Zn = Zn; E.sto = stbuf(ws, v); E.stn = stbuf(ws, v + 1); E.g = lngain(a, v); E.b = lnbias(a, v); E.s = 1.0f; E.pad = 0; run_gemm(F, OCAT, wout, MP, D, D, E, 0); }
        GRID_BAR();
    }
    ffn_step<1>(a, lds, bar, L, false);
}
__global__ void __launch_bounds__(NTHR, 2) mega(Args a) {
    extern __shared__ __attribute__((aligned(16))) unsigned char lds_raw[];
    LAS unsigned char* lds = (LAS unsigned char*)lds_raw;
    for (int u = threadIdx.x; u < (LDS_BYTES - LDSCTL_OFF) / 4; u += NTHR) ((LAS unsigned*)(lds + LDSCTL_OFF))[u] = 0u;
    __syncthreads();
    volatile LAS unsigned* MISC = (volatile LAS unsigned*)(lds + MISC_OFF);
    const XcdBarrier bar = xcd_barrier_post((unsigned*)(a.ws + WS_CTL) + CW_BAR, MISC + 8);
    { const Frame F = mkframe(lds); ph_prologue(F, a); GRID_BAR(); }
    layer<0>(a, lds, bar);
    layer<1>(a, lds, bar);
    layer<2>(a, lds, bar);
    layer<3>(a, lds, bar);
    { const Frame F = mkframe(lds); ph_final(F, a); }
}

extern "C" void kernel_launch(void* const* d_in, const int* in_sizes, int n_in, void* d_out, int out_size, void* d_ws, size_t ws_size, hipStream_t stream) {
    static int grid = 0;
    if (grid == 0) {
        if (n_in != 18 || (size_t)out_size != O_END || ws_size < WS_END) { fprintf(stderr, "kernel_launch: unexpected sizes n_in %d out %d ws %zu (need %zu)\n", n_in, out_size, ws_size, (size_t)WS_END); grid = -1; return; }
        int dev = 0, cus = 0, per_cu = 0;
        if (hipGetDevice(&dev) != hipSuccess || hipDeviceGetAttribute(&cus, hipDeviceAttributeMultiprocessorCount, dev) != hipSuccess) { grid = -1; return; }
        if (hipFuncSetAttribute((const void*)mega, hipFuncAttributeMaxDynamicSharedMemorySize, LDS_BYTES) != hipSuccess) { fprintf(stderr, "kernel_launch: hipFuncSetAttribute failed\n"); grid = -1; return; }
        if (hipOccupancyMaxActiveBlocksPerMultiprocessor(&per_cu, (const void*)mega, NTHR, LDS_BYTES) != hipSuccess || per_cu < 1) { fprintf(stderr, "kernel_launch: occupancy query says %d blocks per CU\n", per_cu); grid = -1; return; }
        (void)hipGetLastError();
        grid = cus;
    }
    if (grid < 0) return;
    if (hipMemsetAsync((char*)d_ws + WS_CTL, 0, CTL_BYTES, stream) != hipSuccess) { fprintf(stderr, "kernel_launch: memset failed\n"); return; }
    Args a{};
    for (int i = 0; i < 18; ++i) a.in[i] = (const float*)d_in[i];
    a.out = (float*)d_out; a.ws = (unsigned char*)d_ws;
    hipLaunchKernelGGL(mega, dim3(grid), dim3(NTHR), LDS_BYTES, stream, a);
}
```

```cpp
#include <hip/hip_runtime.h>
#include <cstdio>
#include <cstdint>
namespace pg8 {
#define PG8_LAS __attribute__((address_space(3)))
typedef unsigned short bf16_t;
typedef short bf16x8 __attribute__((ext_vector_type(8)));
typedef float f32x4 __attribute__((ext_vector_type(4)));
typedef unsigned u32x4 __attribute__((ext_vector_type(4)));
constexpr int BM = 256, BK = 64, HALF = 128, HTB = HALF * BK * 2  , STAGE_BYTES = 8 * HTB, NXCD = 8, WGM = 8;

__host__ __device__ __forceinline__ int lds_byte(int r, int c) { const int st = (r >> 4) * 2 + (c >> 5), rr = r & 15, cc = c & 31, ob = rr * 64 + cc * 2; return st * 1024 + (ob ^ (((ob >> 9) & 1) << 5)); }
__host__ __device__ __forceinline__ void stage_rc(int b, int& R, int& C) { const int st = b / 1024, sb = b % 1024, swz = sb ^ (((sb >> 9) & 1) << 5); R = (st >> 1) * 16 + swz / 64; C = (st & 1) * 32 + (swz % 64) / 2; }
__host__ __device__ __forceinline__ int perm32(int rho) { const int n = rho >> 4, i = rho & 15; return 8 * (i >> 2) + 4 * n + (i & 3); }

struct Unit { int pm, pn; };
struct Gemm { const bf16_t* A; const bf16_t* Bt; int M, N, K; };

struct StaticOrder {
    int nM, nN, nwg, G, c;
    __host__ __device__ void init(int M, int N, int G_, int c_) { nM = M / BM; nN = N / BM; nwg = nM * nN; G = G_; c = c_; }
    __host__ __device__ bool next(int i, Unit& u) const {
        const long L = (long)i * G + c; if (L >= nwg) return false;
        int wgid = (int)L; { const int q = nwg / NXCD, r = nwg % NXCD, xcd = wgid % NXCD, off = wgid / NXCD; wgid = (xcd < r ? xcd * (q + 1) : r * (q + 1) + (xcd - r) * q) + off; }
        const int nig = WGM * nN, gid = wgid / nig, fm = gid * WGM, gsz = (nM - fm) < WGM ? (nM - fm) : WGM;
        u.pm = fm + ((wgid % nig) % gsz); u.pn = (wgid % nig) / gsz; return true;
    }
    __device__ __forceinline__ void a_ready(const Unit&) const {}
    __device__ __forceinline__ void done(const Unit&) const {}
};

__device__ __forceinline__ unsigned cvt_pk_bf16(float lo, float hi) { unsigned r; asm volatile("v_cvt_pk_bf16_f32 %0, %1, %2" : "=v"(r) : "v"(lo), "v"(hi)); return r; }
typedef float f32x2 __attribute__((ext_vector_type(2)));

template <class Epi, class Sched, bool ALIGN_EPI = false, bool SP2 = false>
__device__ __forceinline__ void gemm_phase(PG8_LAS unsigned char* lds, const Gemm g, const Sched& S, const Epi& E) {
    int tid_ = threadIdx.x; asm volatile("" : "+v"(tid_)); const int tid = tid_, wid = __builtin_amdgcn_readfirstlane(tid >> 6), lane = tid & 63, wr = wid >> 2, wc = wid & 3, fr = lane & 15, fq = lane >> 4;
    const int K = g.K, nt = K / BK;
    unsigned voffA[2], voffB[2];
#pragma unroll
    for (int i = 0; i < 2; ++i) { int R, C; stage_rc(tid * 16 + i * 8192, R, C); const int Rb = Epi::PERM ? ((R & ~31) + perm32(R & 31)) : R;
        voffA[i] = (unsigned)(R * K + C) * 2u; voffB[i] = (unsigned)(Rb * K + C) * 2u; }
    const size_t kstep = (size_t)(BK * 2);
    const size_t hstep = (size_t)HALF * K * 2;
    const size_t tstep = 2 * hstep;
    const unsigned ldsw = (unsigned)wid * 1024u;
    const int aoff = lds_byte(wr * 64 + fr, fq * 8), boff = lds_byte(wc * 32 + fr, fq * 8);
#define PG8_SA(b, h) (((b) * 2 + (h)) * HTB)
#define PG8_SB(b, h) ((4 + (b) * 2 + (h)) * HTB)
#define PG8_STAGE(bufoff, gbase, voff) do { _Pragma("unroll") for (int _i = 0; _i < 2; ++_i) \
        __builtin_amdgcn_global_load_lds((const unsigned*)((const char*)(gbase) + (voff)[_i]), (PG8_LAS unsigned*)(lds + (bufoff) + ldsw + _i * 8192), 16, 0, 0); } while (0)
#define PG8_LDA(dst, b, h) do { _Pragma("unroll") for (int m = 0; m < 4; ++m) _Pragma("unroll") for (int k = 0; k < 2; ++k) dst[m][k] = *(const PG8_LAS bf16x8*)(lds + PG8_SA(b, h) + aoff + m * 2048 + k * 1024); } while (0)
#define PG8_LDB(dst, b, h) do { _Pragma("unroll") for (int n = 0; n < 2; ++n) _Pragma("unroll") for (int k = 0; k < 2; ++k) dst[n][k] = *(const PG8_LAS bf16x8*)(lds + PG8_SB(b, h) + boff + n * 2048 + k * 1024); } while (0)
#define PG8_MMA(ai, bj, At, Bt) do { __builtin_amdgcn_s_setprio(1); _Pragma("unroll") for (int m = 0; m < 4; ++m) _Pragma("unroll") for (int n = 0; n < 2; ++n) _Pragma("unroll") for (int k = 0; k < 2; ++k) \
        acc[ai][bj][m][n] = __builtin_amdgcn_mfma_f32_16x16x32_bf16(Bt[n][k], At[m][k], acc[ai][bj][m][n], 0, 0, 0); __builtin_amdgcn_s_setprio(0); } while (0)
#define PG8_WAIT_V(n) asm volatile("s_waitcnt vmcnt(" #n ")" ::: "memory")
#define PG8_WAIT_L(n) asm volatile("s_waitcnt lgkmcnt(" #n ")" ::: "memory")
#define PG8_BAR __builtin_amdgcn_s_barrier()
#define PG8_SCHED __builtin_amdgcn_sched_barrier(0)
    Unit cur, nxt; int ui = 0;
    if (!S.next(0, cur)) return;
    f32x4 acc[2][2][4][2];
#pragma unroll
    for (int a = 0; a < 2; ++a)
#pragma unroll
        for (int b = 0; b < 2; ++b)
#pragma unroll
            for (int m = 0; m < 4; ++m)
#pragma unroll
                for (int n = 0; n < 2; ++n) acc[a][b][m][n] = (f32x4){0.f, 0.f, 0.f, 0.f};
    bf16x8 At[4][2], B0[2][2], B1[2][2];
    const char* cA = (const char*)g.A + (size_t)cur.pm * tstep; const char* cB = (const char*)g.Bt + (size_t)cur.pn * tstep;
    S.a_ready(cur);
    if constexpr (SP2) {
        PG8_STAGE(PG8_SB(0, 0), cB, voffB); PG8_STAGE(PG8_SB(0, 1), cB + hstep, voffB); PG8_STAGE(PG8_SA(0, 0), cA, voffA); PG8_STAGE(PG8_SA(0, 1), cA + hstep, voffA);
        if (wr == 1) PG8_BAR;
        PG8_WAIT_V(2); PG8_BAR;
        PG8_STAGE(PG8_SB(1, 0), cB + kstep, voffB); PG8_STAGE(PG8_SA(1, 0), cA + kstep, voffA); PG8_STAGE(PG8_SB(1, 1), cB + hstep + kstep, voffB);
        PG8_WAIT_V(6); PG8_BAR;
    } else {
        PG8_STAGE(PG8_SB(0, 0), cB, voffB); PG8_STAGE(PG8_SA(0, 0), cA, voffA); PG8_STAGE(PG8_SB(0, 1), cB + hstep, voffB); PG8_STAGE(PG8_SA(0, 1), cA + hstep, voffA);
        if (wr == 1) PG8_BAR;
        PG8_WAIT_V(4); PG8_BAR;
        PG8_STAGE(PG8_SB(1, 0), cB + kstep, voffB); PG8_STAGE(PG8_SA(1, 0), cA + kstep, voffA); PG8_STAGE(PG8_SB(1, 1), cB + hstep + kstep, voffB);
        PG8_WAIT_V(6); PG8_BAR;
    }
    for (;;) {
        const bool has_next = S.next(ui + 1, nxt);
        const char* nA = has_next ? (const char*)g.A + (size_t)nxt.pm * tstep : cA; const char* nB = has_next ? (const char*)g.Bt + (size_t)nxt.pn * tstep : cB;
        for (int t = 0; t < nt; t += 2) {
            const bool last = (t == nt - 2);
            const char* a1 = cA + (size_t)(t + 1) * kstep;
            const char* a2 = last ? nA : cA + (size_t)(t + 2) * kstep; const char* b2 = last ? nB : cB + (size_t)(t + 2) * kstep;
            const char* a3 = a2 + kstep; const char* b3 = b2 + kstep;
            if (last && has_next) S.a_ready(nxt);
            if constexpr (SP2) {
            PG8_LDB(B0, 0, 0); PG8_LDB(B1, 0, 1); PG8_SCHED; PG8_LDA(At, 0, 0); PG8_STAGE(PG8_SA(1, 1), a1 + hstep, voffA);
            PG8_WAIT_V(8); PG8_WAIT_L(0); PG8_BAR; PG8_MMA(0, 0, At, B0); PG8_MMA(0, 1, At, B1); PG8_BAR; PG8_SCHED;
            PG8_LDA(At, 0, 1); PG8_STAGE(PG8_SB(0, 0), b2, voffB); PG8_STAGE(PG8_SB(0, 1), b2 + hstep, voffB); PG8_STAGE(PG8_SA(0, 0), a2, voffA);
            PG8_WAIT_V(8); PG8_WAIT_L(0); PG8_BAR; PG8_MMA(1, 0, At, B0); PG8_MMA(1, 1, At, B1); PG8_BAR; PG8_SCHED;
            PG8_LDB(B0, 1, 0); PG8_LDB(B1, 1, 1); PG8_SCHED; PG8_LDA(At, 1, 0); PG8_STAGE(PG8_SA(0, 1), a2 + hstep, voffA);
            PG8_WAIT_V(8); PG8_WAIT_L(0); PG8_BAR; PG8_MMA(0, 0, At, B0); PG8_MMA(0, 1, At, B1); PG8_BAR; PG8_SCHED;
            PG8_LDA(At, 1, 1); PG8_STAGE(PG8_SB(1, 0), b3, voffB); PG8_STAGE(PG8_SB(1, 1), b3 + hstep, voffB); PG8_STAGE(PG8_SA(1, 0), a3, voffA);
            PG8_WAIT_V(8); PG8_WAIT_L(0); PG8_BAR; PG8_MMA(1, 0, At, B0); PG8_MMA(1, 1, At, B1); PG8_BAR; PG8_SCHED;
            } else {
            PG8_LDB(B0, 0, 0); PG8_SCHED; PG8_LDA(At, 0, 0); PG8_STAGE(PG8_SA(1, 1), a1 + hstep, voffA);
            PG8_WAIT_L(8); PG8_BAR; PG8_WAIT_L(0); PG8_MMA(0, 0, At, B0); PG8_BAR; PG8_SCHED;
            PG8_LDB(B1, 0, 1); PG8_STAGE(PG8_SB(0, 0), b2, voffB);
            PG8_BAR; PG8_WAIT_L(0); PG8_MMA(0, 1, At, B1); PG8_BAR;
            PG8_LDA(At, 0, 1); PG8_STAGE(PG8_SA(0, 0), a2, voffA);
            PG8_BAR; PG8_WAIT_L(0); PG8_MMA(1, 0, At, B0); PG8_BAR; PG8_SCHED;
            PG8_STAGE(PG8_SB(0, 1), b2 + hstep, voffB);
            PG8_WAIT_V(6); PG8_BAR; PG8_MMA(1, 1, At, B1); PG8_BAR;
            PG8_LDB(B0, 1, 0); PG8_SCHED; PG8_LDA(At, 1, 0); PG8_STAGE(PG8_SA(0, 1), a2 + hstep, voffA);
            PG8_WAIT_L(8); PG8_BAR; PG8_WAIT_L(0); PG8_MMA(0, 0, At, B0); PG8_BAR; PG8_SCHED;
            PG8_LDB(B1, 1, 1); PG8_STAGE(PG8_SB(1, 0), b3, voffB);
            PG8_BAR; PG8_WAIT_L(0); PG8_MMA(0, 1, At, B1); PG8_BAR;
            PG8_LDA(At, 1, 1); PG8_STAGE(PG8_SA(1, 0), a3, voffA);
            PG8_BAR; PG8_WAIT_L(0); PG8_MMA(1, 0, At, B0); PG8_BAR; PG8_SCHED;
            PG8_STAGE(PG8_SB(1, 1), b3 + hstep, voffB);
            PG8_WAIT_V(6); PG8_BAR; PG8_MMA(1, 1, At, B1); PG8_BAR;
            }
        }
        if constexpr (ALIGN_EPI) { if (wr == 0) PG8_BAR; }
        if constexpr (!Epi::AFTER_DRAIN) { E(acc, cur, wr, wc, fr, fq); S.done(cur); }
        if (!has_next) break;
#pragma unroll
        for (int a = 0; a < 2; ++a)
#pragma unroll
            for (int b = 0; b < 2; ++b)
#pragma unroll
                for (int m = 0; m < 4; ++m)
#pragma unroll
                    for (int n = 0; n < 2; ++n) acc[a][b][m][n] = (f32x4){0.f, 0.f, 0.f, 0.f};
        cur = nxt; cA = nA; cB = nB; ++ui;
        if constexpr (ALIGN_EPI) { if (wr == 1) PG8_BAR; }
    }
    PG8_WAIT_V(0);
    if constexpr (!ALIGN_EPI) { if (wr == 0) PG8_BAR; }
    PG8_BAR;
    if constexpr (Epi::AFTER_DRAIN) { E.fused(acc, cur, wr, wc, fr, fq, lds, wid, lane); S.done(cur); }
#undef PG8_SA
#undef PG8_SB
#undef PG8_STAGE
#undef PG8_LDA
#undef PG8_LDB
#undef PG8_MMA
#undef PG8_WAIT_V
#undef PG8_WAIT_L
#undef PG8_BAR
#undef PG8_SCHED
}
}

#define GAS __attribute__((address_space(1)))
#define LAS __attribute__((address_space(3)))
typedef unsigned short bf16;
typedef unsigned v4u __attribute__((ext_vector_type(4)));
typedef float f32x4 __attribute__((ext_vector_type(4)));
typedef short bf16x8 __attribute__((ext_vector_type(8)));
typedef GAS unsigned gu32;
typedef GAS unsigned long long gu64;
#define RLX_AGENT __ATOMIC_RELAXED, __HIP_MEMORY_SCOPE_AGENT
#define LDS_WAIT() asm volatile("s_waitcnt lgkmcnt(0)" ::: "memory")
#define VM_WAIT() asm volatile("s_waitcnt vmcnt(0)" ::: "memory")
__device__ __forceinline__ unsigned long long rt() { return __builtin_amdgcn_s_memrealtime(); }
__device__ __forceinline__ unsigned f2bf(float f) { unsigned u = __builtin_bit_cast(unsigned, f); return (u + 0x7fffu + ((u >> 16) & 1u)) >> 16; }
__device__ __forceinline__ unsigned pk2(float lo, float hi) { return f2bf(lo) | (f2bf(hi) << 16); }

#define XB_TMO      128
#define XB_XCNT(j)  (256  + 64 * (j))
#define XB_XSUB(j)  (1280 + 64 * (j))
#define XB_XGEN(j)  (2304 + 64 * (j))
#define XB_TOP      3328
#define XB_TOPGEN   3392
#define XCD_BAR_WORDS 3456
#define XB_SPIN_CAP (1u << 18)

__device__ __forceinline__ unsigned xb_ld(unsigned* p)              { return __hip_atomic_load(p, __ATOMIC_RELAXED, __HIP_MEMORY_SCOPE_AGENT); }
__device__ __forceinline__ unsigned xb_add(unsigned* p, unsigned v) { return __hip_atomic_fetch_add(p, v, __ATOMIC_RELAXED, __HIP_MEMORY_SCOPE_AGENT); }
__device__ __forceinline__ unsigned xb_xcc_id() { return (unsigned)__builtin_amdgcn_s_getreg((3 << 11) | 20) & 0xFu; }
#define XB_SPIN(cond, bar) do { unsigned _sp = 0; while (cond) { __builtin_amdgcn_s_sleep(1); \
    if ((++_sp & 255u) == 0u) { if (xb_ld(&(bar)[XB_TMO])) break; if (_sp > XB_SPIN_CAP) { atomicAdd(&(bar)[XB_TMO], 1u); break; } } } } while (0)

struct XcdBarrier {
    unsigned* bar; unsigned x;
    volatile LAS unsigned* st;
};

__device__ __forceinline__ XcdBarrier xcd_barrier_post(unsigned* bar, volatile LAS unsigned* st) {
    XcdBarrier b; b.bar = bar; b.x = xb_xcc_id(); b.st = st;
    if (threadIdx.x == 0) (void)xb_add(&bar[XB_XCNT(b.x)], 1u);
    return b;
}
__device__ __forceinline__ void xcd_barrier_complete(unsigned* bar, unsigned x, unsigned& nloc, unsigned& nx) {
    const unsigned G = gridDim.x * gridDim.y * gridDim.z;
    unsigned sum, cnt, mine, sp = 0u;
    for (;;) {
        sum = 0u; cnt = 0u; mine = 0u;
#pragma unroll
        for (unsigned j = 0; j < 16; ++j) { const unsigned c = xb_ld(&bar[XB_XCNT(j)]); sum += c; cnt += (c > 0u) ? 1u : 0u; mine = (j == x) ? c : mine; }
        if (sum == G) break;
        __builtin_amdgcn_s_sleep(1);
        if ((++sp & 255u) == 0u) { if (xb_ld(&bar[XB_TMO])) break; if (sp > XB_SPIN_CAP) { atomicAdd(&bar[XB_TMO], 1u); break; } }
    }
    nloc = mine > 0u ? mine : 1u; nx = cnt > 0u ? cnt : 1u;
}

__device__ __forceinline__ void xcd_barrier(const XcdBarrier& b) {
    asm volatile("s_waitcnt vmcnt(0)" ::: "memory");
    __syncthreads();
    if (threadIdx.x == 0) {
        unsigned* bar = b.bar;
        __builtin_amdgcn_s_waitcnt(0);
        unsigned nloc = b.st[0], nx = b.st[1];
        if (nloc == 0u) { xcd_barrier_complete(bar, b.x, nloc, nx); b.st[0] = nloc; b.st[1] = nx; }
        const unsigned old = xb_add(&bar[XB_XSUB(b.x)], 1u);
        const unsigned gen = old / nloc;
        if (old + 1u == (gen + 1u) * nloc) {
            __builtin_amdgcn_fence(__ATOMIC_RELEASE, "agent");
            asm volatile("s_waitcnt vmcnt(0)" ::: "memory");
            const unsigned og = xb_add(&bar[XB_TOP], 1u);
            const unsigned tg = og / nx;
            if (og + 1u == (tg + 1u) * nx) xb_add(&bar[XB_TOPGEN], 1u);
            else XB_SPIN(xb_ld(&bar[XB_TOPGEN]) == tg, bar);
            __builtin_amdgcn_fence(__ATOMIC_ACQUIRE, "agent");
            xb_add(&bar[XB_XGEN(b.x)], 1u);
            asm volatile("s_waitcnt vmcnt(0)" ::: "memory");
        } else {
            XB_SPIN(xb_ld(&bar[XB_XGEN(b.x)]) == gen, bar);
            __builtin_amdgcn_fence(__ATOMIC_ACQUIRE, "agent");
            asm volatile("s_waitcnt vmcnt(0)" ::: "memory");
        }
    }
    __syncthreads();
}


constexpr int D = 2048, DFF = 5632, NGU = 2 * DFF, NB = 4, SEQ = 2048, MP = NB * SEQ, SB = 32, MR = MP + SB, MT = 8448;
constexpr int DEPTH = 4, PAST = 16384;
constexpr int SWA_IN = 3072, RET_IN = 5120;
constexpr float LN_EPS = 1e-5f, HN_EPS = 1e-6f;
constexpr float ALPHA = 1.6817928305074292f;
constexpr float QSCALE = 0.08838834764831845f;
constexpr int NWAVES = 8, NTHR = 512;

__device__ __forceinline__ float wave_sum(float v) {
#pragma unroll
    for (int o = 1; o < 64; o <<= 1) v += __shfl_xor(v, o);
    return v;
}
__device__ __forceinline__ float silu_f(float x) { return x * __builtin_amdgcn_rcpf(1.0f + __expf(-x)); }

constexpr size_t WS_CTL = 0, CTL_BYTES = 2u << 20;
constexpr int CW_BAR = 4096, CW_Q = 64;
constexpr size_t CTL_ST = 65536, ST_BYTES = (size_t)MP * 16;
constexpr float ST_SCALE = 16777216.0f, ST_INV = 1.0f / 16777216.0f;
__device__ __forceinline__ float ll2f(long long v) { return (float)(int)(v >> 32) * 4294967296.0f + (float)(unsigned)v; }
static_assert(CTL_ST + 13 * ST_BYTES <= CTL_BYTES, "ctl");
constexpr size_t SZ_WGU = (size_t)NGU * D * 2, SZ_WDN = (size_t)D * DFF * 2, SZ_WINS = (size_t)SWA_IN * D * 2, SZ_WINR = (size_t)RET_IN * D * 2, SZ_WOUT = (size_t)D * D * 2;
constexpr size_t WS_WGU = WS_CTL + CTL_BYTES;
constexpr size_t WS_WDN = WS_WGU + 8 * SZ_WGU;
constexpr size_t WS_WINS = WS_WDN + 8 * SZ_WDN;
constexpr size_t WS_WINR = WS_WINS + 2 * SZ_WINS;
constexpr size_t WS_WOUT = WS_WINR + 2 * SZ_WINR;
constexpr size_t WS_WMEM = WS_WOUT + 4 * SZ_WOUT;
constexpr size_t WS_C1GU = WS_WMEM + (size_t)4096 * D * 2;
constexpr size_t WS_C1INS = WS_C1GU + (size_t)2 * 8 * NGU * 4;
constexpr size_t WS_C1INR = WS_C1INS + (size_t)2 * 2 * SWA_IN * 4;
constexpr size_t WS_ONES = WS_C1INR + (size_t)2 * 2 * RET_IN * 4;
constexpr size_t WS_ROPE = WS_ONES + (size_t)2 * D * 4;
constexpr size_t WS_RETCS = WS_ROPE + (size_t)SEQ * 16 * 8;
constexpr size_t WS_XMEMB = WS_RETCS + (size_t)SEQ * 64 * 8;
constexpr size_t WS_Z = WS_XMEMB + (size_t)1024 * D * 2;
constexpr size_t SZ_Z = (size_t)MT * D * 2;
constexpr size_t WS_H = WS_Z + 2 * SZ_Z;
constexpr size_t WS_QKV = WS_H + (size_t)MT * DFF * 2;
constexpr size_t WS_ORAW = WS_QKV + (size_t)MT * RET_IN * 4;
constexpr size_t WS_OCAT = WS_ORAW + (size_t)MT * 1536 * 4;
constexpr size_t WS_QKVB = WS_OCAT + (size_t)MT * D * 2;
constexpr size_t WS_DST = WS_QKVB + (size_t)MT * RET_IN * 2;
constexpr size_t WS_SC = WS_DST + (size_t)NB * 6 * 16 * 32768 * 4;
constexpr size_t WS_MEMKB = WS_SC + (size_t)NB * 6 * 16 * 32768 * 2;
constexpr size_t WS_END = WS_MEMKB + (size_t)4 * 1024 * 1024 * 2;

constexpr size_t O_YP = 0, O_YS = O_YP + (size_t)MP * D, O_SKP = O_YS + (size_t)SB * D, O_SVP = O_SKP + 2 * 4 * 128 * 512, O_SKS = O_SVP + 2 * 4 * 128 * 512,
                 O_SVS = O_SKS + (size_t)2 * 32 * 128 * 512, O_RSP = O_SVS + (size_t)2 * 32 * 128 * 512, O_RSS = O_RSP + (size_t)2 * 4 * 6 * 128 * 256,
                 O_MK = O_RSS + (size_t)2 * 32 * 6 * 128 * 256, O_MV = O_MK + (size_t)4 * 4 * 256 * 512, O_END = O_MV + (size_t)4 * 4 * 256 * 512;

constexpr int RING_OFF = 0, RING_BYTES = 131072;
constexpr int LDSCTL_OFF = 147456, MISC_OFF = LDSCTL_OFF + 320;
constexpr int SSTAT_OFF = LDSCTL_OFF + 512;
constexpr int LDS_BYTES = LDSCTL_OFF + 1024;

struct Args { const float* in[18]; float* out; unsigned char* ws; };

struct Frame {
    LAS unsigned char* lds;
    int tid, lane, wave, G, bid;
    size_t gtid, ngt; int gw, ngw;
};
__device__ __forceinline__ bf16* zbuf(unsigned char* ws, int v) { return (bf16*)(ws + WS_Z + (size_t)(v & 1) * SZ_Z); }
__device__ __forceinline__ long long* stbuf(unsigned char* ws, int v) { return (long long*)(ws + WS_CTL + CTL_ST + (size_t)v * ST_BYTES); }
__device__ __forceinline__ const float* lngain(const Args& a, int v) { return v ? a.in[8] + (size_t)(v - 1) * D : (const float*)(a.ws + WS_ONES); }
__device__ __forceinline__ const float* lnbias(const Args& a, int v) { return v ? a.in[9] + (size_t)(v - 1) * D : (const float*)(a.ws + WS_ONES) + D; }
__device__ __forceinline__ float bf2f(unsigned h) { return __builtin_bit_cast(float, h << 16); }
__device__ __forceinline__ unsigned f2bfh(float f) { unsigned u = __builtin_bit_cast(unsigned, f); u += 0x1ffffu + ((u >> 18) & 1u); return (u >> 18) << 2; }
__device__ __forceinline__ unsigned pkh(float lo, float hi) { return f2bfh(lo) | (f2bfh(hi) << 16); }

typedef float f32x2_t __attribute__((ext_vector_type(2)));
typedef long long i64x2_t __attribute__((ext_vector_type(2)));
__device__ __forceinline__ void row_stats(const long long* st, int row, float& mu, float& rstd) {
    const i64x2_t s = *(const i64x2_t*)(st + 2 * (size_t)row); mu = ll2f(s.x) * (ST_INV / D); const float var = ll2f(s.y) * (ST_INV / D) - mu * mu; rstd = __builtin_amdgcn_rsqf(fmaxf(var, 0.f) + LN_EPS);
}
struct EpiGU {
    static constexpr bool PERM = true, AFTER_DRAIN = false;
    bf16* H; const long long* st; const float* c1; const float* c2;
    __device__ __forceinline__ void operator()(const f32x4 (&acc)[2][2][4][2], const pg8::Unit& u, int wr, int wc, int fr, int fq) const {
        const int row0 = u.pm * 256 + wr * 64 + fr, s0 = u.pn * 256 + wc * 32 + 8 * fq, hc0 = u.pn * 128 + wc * 32 + 8 * fq;
        f32x4 k1[2][2], k2[2][2];
#pragma unroll
        for (int bj = 0; bj < 2; ++bj)
#pragma unroll
            for (int n = 0; n < 2; ++n) { k1[bj][n] = *(const f32x4*)(c1 + s0 + 128 * bj + 4 * n); k2[bj][n] = *(const f32x4*)(c2 + s0 + 128 * bj + 4 * n); }
#pragma unroll
        for (int ai = 0; ai < 2; ++ai) {
            float mu4[4], rs4[4];
            { i64x2_t s4[4];
#pragma unroll
              for (int m = 0; m < 4; ++m) s4[m] = *(const i64x2_t*)(st + 2 * (size_t)(row0 + ai * 128 + m * 16));
#pragma unroll
              for (int m = 0; m < 4; ++m) { mu4[m] = ll2f(s4[m].x) * (ST_INV / D); const float var = ll2f(s4[m].y) * (ST_INV / D) - mu4[m] * mu4[m]; rs4[m] = __builtin_amdgcn_rsqf(fmaxf(var, 0.f) + LN_EPS); } }
#pragma unroll
            for (int m = 0; m < 4; ++m) { const int row = row0 + ai * 128 + m * 16; const float mu = mu4[m], rs = rs4[m];
                float h[8];
#pragma unroll
                for (int n = 0; n < 2; ++n)
#pragma unroll
                    for (int e = 0; e < 4; ++e) { const float g = rs * (acc[ai][0][m][n][e] - mu * k1[0][n][e]) + k2[0][n][e], uu = rs * (acc[ai][1][m][n][e] - mu * k1[1][n][e]) + k2[1][n][e]; h[4 * n + e] = silu_f(g) * uu; }
                v4u w; w.x = pkh(h[0], h[1]); w.y = pkh(h[2], h[3]); w.z = pkh(h[4], h[5]); w.w = pkh(h[6], h[7]);
                *(v4u*)(H + (size_t)row * DFF + hc0) = w; }
        }
    }
};
struct EpiRes {
    static constexpr bool PERM = true, AFTER_DRAIN = false;
    const bf16* Zo; bf16* Zn; const long long* sto; long long* stn; const float* g; const float* b; float s; int pad;
    __device__ __forceinline__ void operator()(const f32x4 (&acc)[2][2][4][2], const pg8::Unit& u, int wr, int wc, int fr, int fq) const {
        const int row0 = u.pm * 256 + wr * 64 + fr, c0 = u.pn * 256 + wc * 32 + 8 * fq;
#pragma unroll
        for (int bj = 0; bj < 2; ++bj) {
            const int cb = c0 + 128 * bj;
            const f32x4 ga0 = *(const f32x4*)(g + cb) * ALPHA, ga1 = *(const f32x4*)(g + cb + 4) * ALPHA, ba0 = *(const f32x4*)(b + cb) * ALPHA, ba1 = *(const f32x4*)(b + cb + 4) * ALPHA;
#pragma unroll
            for (int ai = 0; ai < 2; ++ai) {
                v4u zo4[4]; i64x2_t st4[4];
#pragma unroll
                for (int m = 0; m < 4; ++m) { const int row = row0 + ai * 128 + m * 16; zo4[m] = *(const v4u*)(Zo + (size_t)row * D + cb); st4[m] = *(const i64x2_t*)(sto + 2 * (size_t)row); }
#pragma unroll
                for (int m = 0; m < 4; ++m) { const int row = row0 + ai * 128 + m * 16;
                    const float mu = ll2f(st4[m].x) * (ST_INV / D), var = ll2f(st4[m].y) * (ST_INV / D) - mu * mu, rs = __builtin_amdgcn_rsqf(fmaxf(var, 0.f) + LN_EPS);
                    const v4u zo = zo4[m]; float z[8];
#pragma unroll
                    for (int n = 0; n < 2; ++n)
#pragma unroll
                        for (int e = 0; e < 4; ++e) { const unsigned wd = zo[2 * n + (e >> 1)]; const float zf = bf2f((e & 1) ? (wd >> 16) : (wd & 0xffffu));
                            z[4 * n + e] = (zf - mu) * rs * (n ? ga1[e] : ga0[e]) + (n ? ba1[e] : ba0[e]) + s * acc[ai][bj][m][n][e]; }
                    v4u w; w.x = pk2(z[0], z[1]); w.y = pk2(z[2], z[3]); w.z = pk2(z[4], z[5]); w.w = pk2(z[6], z[7]);
                    *(v4u*)(Zn + (size_t)row * D + cb) = w;
                    float sum = 0.f, sq = 0.f;
#pragma unroll
                    for (int q = 0; q < 4; ++q) { const float lo = bf2f(w[q] & 0xffffu), hi = bf2f(w[q] >> 16); sum += lo + hi; sq += lo * lo + hi * hi; }
                    sum += __shfl_xor(sum, 16); sum += __shfl_xor(sum, 32); sq += __shfl_xor(sq, 16); sq += __shfl_xor(sq, 32);
                    if (fq < 2 && pad == 0) __hip_atomic_fetch_add((unsigned long long*)(stn + 2 * (size_t)row + fq), (unsigned long long)__float2ll_rn((fq ? sq : sum) * ST_SCALE), __ATOMIC_RELAXED, __HIP_MEMORY_SCOPE_AGENT); }
                asm volatile("" ::: "memory");
            }
        }
    }
};
template <int KIND> struct EpiIn {
    static constexpr bool PERM = true, AFTER_DRAIN = false;
    bf16* QB; const long long* st; const float* c1; const float* c2; const f32x4* rope; const f32x4* retcs; float* out; int jl, pad;
    __device__ __forceinline__ void operator()(const f32x4 (&acc)[2][2][4][2], const pg8::Unit& u, int wr, int wc, int fr, int fq) const {
        constexpr int N = KIND == 0 ? SWA_IN : RET_IN;
        constexpr int NT = KIND == 0 ? 4 : 2;
        const int row0 = u.pm * 256 + wr * 64 + fr, c0 = u.pn * 256 + wc * 32 + 8 * fq, pn = u.pn;
        const bool rot = KIND == 0 ? (pn < 8 && wc == 0) : (pn < 6);
#pragma unroll
        for (int bj = 0; bj < 2; ++bj) {
            const int cb = c0 + 128 * bj;
            const f32x4 k10 = *(const f32x4*)(c1 + cb), k11 = *(const f32x4*)(c1 + cb + 4), k20 = *(const f32x4*)(c2 + cb), k21 = *(const f32x4*)(c2 + cb + 4);
#pragma unroll
            for (int ai = 0; ai < 2; ++ai) {
                i64x2_t st4[4];
#pragma unroll
                for (int m = 0; m < 4; ++m) st4[m] = *(const i64x2_t*)(st + 2 * (size_t)(row0 + ai * 128 + m * 16));
#pragma unroll
                for (int mp = 0; mp < 2; ++mp) {
                    f32x4 tb[2][NT];
                    if (rot) {
#pragma unroll
                        for (int q2 = 0; q2 < 2; ++q2) { const int pos = (row0 + ai * 128 + (2 * mp + q2) * 16) & (SEQ - 1);
                            const f32x4* cs = KIND == 0 ? rope + (size_t)pos * 8 + 4 * (fq & 1) : retcs + (size_t)pos * 32 + ((cb & 127) >> 2);
#pragma unroll
                            for (int q = 0; q < NT; ++q) tb[q2][q] = cs[q]; }
                    }
#pragma unroll
                    for (int q2 = 0; q2 < 2; ++q2) { const int m = 2 * mp + q2, row = row0 + ai * 128 + m * 16, pos = row & (SEQ - 1);
                        const float mu = ll2f(st4[m].x) * (ST_INV / D), var = ll2f(st4[m].y) * (ST_INV / D) - mu * mu, rs = __builtin_amdgcn_rsqf(fmaxf(var, 0.f) + LN_EPS);
                        float v[8];
#pragma unroll
                        for (int e = 0; e < 4; ++e) { v[e] = rs * (acc[ai][bj][m][0][e] - mu * k10[e]) + k20[e]; v[4 + e] = rs * (acc[ai][bj][m][1][e] - mu * k11[e]) + k21[e]; }
                        if (KIND == 0) {
                            if (rot) {
#pragma unroll
                                for (int q = 0; q < 4; ++q) { const f32x4 t = tb[q2][q];
#pragma unroll
                                    for (int hh = 0; hh < 2; ++hh) { const int jx = 2 * q + hh; const float c = hh ? t[2] : t[0], sn = hh ? t[3] : t[1]; const float o = __shfl_xor(v[jx], 32);
                                        v[jx] = (fq < 2) ? v[jx] * c - o * sn : v[jx] * c + o * sn; } }
                            }
                            if (pn >= 6 && pn < 10 && pos >= SEQ - 128) {
                                float* o = out + (pn < 8 ? O_SKP : O_SVP) + (((size_t)jl * NB + (row >> 11)) * 128 + (pos - (SEQ - 128))) * 512 + (cb - (pn < 8 ? 1536 : 2048));
                                *(f32x4*)o = (f32x4){v[0], v[1], v[2], v[3]}; *(f32x4*)(o + 4) = (f32x4){v[4], v[5], v[6], v[7]}; }
                        } else {
                            if (rot) {
                                const float sc = pn < 3 ? 1.0f : QSCALE;
#pragma unroll
                                for (int q = 0; q < 2; ++q) { const f32x4 t = tb[q2][q];
#pragma unroll
                                    for (int hh = 0; hh < 2; ++hh) { const int jx = 4 * q + 2 * hh; const float c = hh ? t[2] : t[0], sn = hh ? t[3] : t[1]; const float x1 = v[jx], x2 = v[jx + 1];
                                        v[jx] = (x1 * c - x2 * sn) * sc; v[jx + 1] = (x2 * c + x1 * sn) * sc; } }
                            }
                        }
                        v4u w; w.x = pk2(v[0], v[1]); w.y = pk2(v[2], v[3]); w.z = pk2(v[4], v[5]); w.w = pk2(v[6], v[7]);
                        *(v4u*)(QB + (size_t)row * N + cb) = w; }
                }
                asm volatile("" ::: "memory");
            }
        }
    }
};
struct EpiMem {
    static constexpr bool PERM = true, AFTER_DRAIN = false;
    float* out; bf16* MKB;
    __device__ __forceinline__ void operator()(const f32x4 (&acc)[2][2][4][2], const pg8::Unit& u, int wr, int wc, int fr, int fq) const {
        const int row0 = u.pm * 256 + wr * 64 + fr, l = u.pn >> 2, e0 = (u.pn & 3) * 256 + wc * 32 + 8 * fq;
#pragma unroll
        for (int ai = 0; ai < 2; ++ai)
#pragma unroll
            for (int m = 0; m < 4; ++m) { const int row = row0 + ai * 128 + m * 16;
#pragma unroll
                for (int bj = 0; bj < 2; ++bj) { const int e = e0 + 128 * bj; const f32x4 a0 = acc[ai][bj][m][0], a1 = acc[ai][bj][m][1];
                    float* o = out + (e < 512 ? O_MK : O_MV) + ((size_t)l * 1024 + row) * 512 + (e & 511);
                    *(f32x4*)o = a0; *(f32x4*)(o + 4) = a1;
                    v4u w; w.x = pk2(a0[0], a0[1]); w.y = pk2(a0[2], a0[3]); w.z = pk2(a1[0], a1[1]); w.w = pk2(a1[2], a1[3]);
                    *(v4u*)(MKB + ((size_t)l * 1024 + row) * 1024 + e) = w; } }
    }
};
typedef short s16x4 __attribute__((ext_vector_type(4)));
typedef short v4i16_t __attribute__((ext_vector_type(4)));
#define MFMA16(a, b, c) __builtin_amdgcn_mfma_f32_16x16x32_bf16((a), (b), (c), 0, 0, 0)
constexpr float LOG2E = 1.4426950408889634f;
__device__ __forceinline__ s16x4 ds_tr(LAS unsigned char* p) { return __builtin_bit_cast(s16x4, __builtin_amdgcn_ds_read_tr16_b64_v4i16((LAS v4i16_t*)p)); }
__device__ __forceinline__ bf16x8 frag_tr(LAS unsigned char* base, int rowA, int rowB, int c0, int pitch, int tq, int tp) {
    const s16x4 lo = ds_tr(base + (rowA + tq) * pitch + (c0 + 4 * tp) * 2), hi = ds_tr(base + (rowB + tq) * pitch + (c0 + 4 * tp) * 2);
    return __builtin_shufflevector(lo, hi, 0, 1, 2, 3, 4, 5, 6, 7);
}
__device__ __forceinline__ bf16x8 pack_bf8(f32x4 a, f32x4 b) { v4u w; w.x = pk2(a[0], a[1]); w.y = pk2(a[2], a[3]); w.z = pk2(b[0], b[1]); w.w = pk2(b[2], b[3]); return __builtin_bit_cast(bf16x8, w); }

constexpr int KP = 272;
constexpr int VP2 = 528;
__device__ __forceinline__ void attn_unit(LAS unsigned char* lds, int tid, const bf16* Qb, int ldq, int nqt, const bf16* K0, const bf16* K1, const bf16* V0, const bf16* V1, int ldk,
                                          bf16* Ob, int ldo, int lo, int hi, int kmin, const float* sinks) {
    const int lane = tid & 63, w = __builtin_amdgcn_readfirstlane(tid >> 6), r16 = lane & 15, g = lane >> 4, tq = r16 >> 2, tp = r16 & 3;
    LAS unsigned char* Kt = lds; LAS unsigned char* Vt = lds + 256 * KP;
    __syncthreads();
#pragma unroll
    for (int it = 0; it < 8; ++it) { const int row = it * 32 + (tid >> 4), ch = tid & 15;
        const v4u kv = *(const v4u*)((row < 128 ? K0 : K1) + (size_t)(row & 127) * ldk + ch * 8), vv = *(const v4u*)((row < 128 ? V0 : V1) + (size_t)(row & 127) * ldk + ch * 8);
        *(LAS v4u*)(Kt + row * KP + ch * 16) = kv; *(LAS v4u*)(Vt + row * KP + ch * 16) = vv; }
    __syncthreads();
    int klo = 16 * w + lo; if (klo < kmin) klo = kmin; if (klo < 0) klo = 0; int khi = 16 * w + 15 + hi; if (khi > 255) khi = 255;
    const int nt_lo = klo >> 4, nt_hi = khi >> 4;
    const int qi = 16 * w + r16;
    for (int qt = 0; qt < nqt; ++qt) {
        const bf16* qp = Qb + (size_t)qi * ldq + qt * 128 + 8 * g;
        bf16x8 qf[4];
#pragma unroll
        for (int ks = 0; ks < 4; ++ks) qf[ks] = *(const bf16x8*)(qp + 32 * ks);
        f32x4 s[16];
#pragma unroll
        for (int nt = 0; nt < 16; ++nt) { s[nt] = (f32x4){0.f, 0.f, 0.f, 0.f};
            if (nt >= nt_lo && nt <= nt_hi) {
#pragma unroll
                for (int ks = 0; ks < 4; ++ks) { const bf16x8 kf = *(const LAS bf16x8*)(Kt + (16 * nt + r16) * KP + (32 * ks + 8 * g) * 2); s[nt] = MFMA16(kf, qf[ks], s[nt]); } } }
        const float NEG = -__builtin_inff(); float mx = NEG;
#pragma unroll
        for (int nt = 0; nt < 16; ++nt)
#pragma unroll
            for (int r = 0; r < 4; ++r) { const int kk = 16 * nt + 4 * g + r; const bool ok = (nt >= nt_lo) && (nt <= nt_hi) && (kk >= kmin) && (kk >= qi + lo) && (kk <= qi + hi);
                const float v = ok ? s[nt][r] * (QSCALE * LOG2E) : NEG; s[nt][r] = v; mx = fmaxf(mx, v); }
        mx = fmaxf(mx, __shfl_xor(mx, 16)); mx = fmaxf(mx, __shfl_xor(mx, 32));
        const float snk = sinks ? sinks[qt] * LOG2E : NEG;
        const float M = fmaxf(mx, snk); float l = 0.f;
#pragma unroll
        for (int nt = 0; nt < 16; ++nt)
#pragma unroll
            for (int r = 0; r < 4; ++r) { const float p = __builtin_amdgcn_exp2f(s[nt][r] - M); s[nt][r] = p; l += p; }
        l += __shfl_xor(l, 16); l += __shfl_xor(l, 32); l += __builtin_amdgcn_exp2f(snk - M);
        const float il = 1.0f / l;
        f32x4 o[8];
#pragma unroll
        for (int mt = 0; mt < 8; ++mt) o[mt] = (f32x4){0.f, 0.f, 0.f, 0.f};
#pragma unroll
        for (int ks = 0; ks < 8; ++ks) {
            if (2 * ks + 1 >= nt_lo && 2 * ks <= nt_hi) {
                const bf16x8 pf = pack_bf8(s[2 * ks], s[2 * ks + 1]);
#pragma unroll
                for (int mt = 0; mt < 8; ++mt) { const bf16x8 vf = frag_tr(Vt, 32 * ks + 4 * g, 32 * ks + 16 + 4 * g, 16 * mt, KP, tq, tp); o[mt] = MFMA16(vf, pf, o[mt]); } } }
        bf16* op = Ob + (size_t)qi * ldo + qt * 128 + 4 * g;
#pragma unroll
        for (int mt = 0; mt < 8; ++mt) { uint2 u; u.x = pk2(o[mt][0] * il, o[mt][1] * il); u.y = pk2(o[mt][2] * il, o[mt][3] * il); *(uint2*)(op + 16 * mt) = u; }
    }
}
__device__ __forceinline__ void ph_attn_mfma(const Frame& F, const Args& a, int L, bool is_swa, int tf) {
    const bf16* QB = (const bf16*)(a.ws + WS_QKVB); bf16* OCAT = (bf16*)(a.ws + WS_OCAT); const bf16* MKB = (const bf16*)(a.ws + WS_MEMKB) + (size_t)L * 1024 * 1024;
    const int pitch = is_swa ? SWA_IN : RET_IN, qoff = is_swa ? 2560 : 4608, j = L / 2;
    const int n_swa = is_swa ? NB * 4 * 16 : 0, n_all = n_swa + NB * 4 * 16;
    for (int u = F.bid - tf; u < n_all; u += F.G - tf) {
        if (u < 0) break;
        if (u < n_swa) { const int qb = u % 16, kvh = (u / 16) % 4, b = u / 64; const size_t r1 = (size_t)b * SEQ + 128 * qb, r0 = qb ? r1 - 128 : r1;
            const bf16* kb = QB + 1536 + kvh * 128;
            attn_unit(F.lds, F.tid, QB + r1 * SWA_IN + 3 * kvh * 128, SWA_IN, 3, kb + r0 * SWA_IN, kb + r1 * SWA_IN, kb + 512 + r0 * SWA_IN, kb + 512 + r1 * SWA_IN, SWA_IN,
                      OCAT + r1 * D + 3 * kvh * 128, D, 0, 128, qb ? 0 : 128, a.in[15] + j * 12 + 3 * kvh);
        } else { const int uu = u - n_swa, qb = uu % 16, h = (uu / 16) % 4, b = uu / 64; const size_t r1 = (size_t)b * SEQ + 128 * qb;
            const bf16* kb = MKB + (size_t)(b * 256) * 1024 + h * 128;
            attn_unit(F.lds, F.tid, QB + r1 * pitch + qoff + h * 128, pitch, 1, kb, kb + (size_t)128 * 1024, kb + 512, kb + 512 + (size_t)128 * 1024, 1024,
                      OCAT + r1 * D + 1536 + h * 128, D, -1024, 1024, 0, nullptr);
        }
    }
    __syncthreads();
}
template <int NH, int NKW, bool EXTRA>
__device__ __forceinline__ void decode_unit(LAS unsigned char* lds, int tid, const float* qp, const float* kc, const float* vc, const float* kx, const float* vx, const float* sinks,
                                            bf16* op, float* kout, float* vout) {
    const int lane = tid & 63, w = __builtin_amdgcn_readfirstlane(tid >> 6);
    LAS float* pm = (LAS float*)lds; LAS float* pa = pm + 64;
    f32x2_t q[NH], kr[NKW], vr[NKW], kxr = {0.f, 0.f}, vxr = {0.f, 0.f};
#pragma unroll
    for (int h = 0; h < NH; ++h) q[h] = *(const f32x2_t*)(qp + 128 * h);
#pragma unroll
    for (int i = 0; i < NKW; ++i) { const size_t j = (size_t)(w * NKW + i) * 512; kr[i] = *(const f32x2_t*)(kc + j); vr[i] = *(const f32x2_t*)(vc + j); }
    const bool ext = EXTRA && w == 7;
    if (ext) { kxr = *(const f32x2_t*)kx; vxr = *(const f32x2_t*)vx; }
    if (kout) {
#pragma unroll
        for (int i = 0; i < NKW; ++i) { const int j = w * NKW + i; if (j >= 1) { *(f32x2_t*)(kout + (size_t)(j - 1) * 512) = kr[i]; *(f32x2_t*)(vout + (size_t)(j - 1) * 512) = vr[i]; } }
        if (ext) { *(f32x2_t*)(kout + (size_t)(8 * NKW - 1) * 512) = kxr; *(f32x2_t*)(vout + (size_t)(8 * NKW - 1) * 512) = vxr; }
    }
    __syncthreads();
#pragma unroll
    for (int h = 0; h < NH; ++h) {
        float s[NKW], m = -1e30f, sx = -1e30f;
#pragma unroll
        for (int i = 0; i < NKW; ++i) { s[i] = wave_sum(q[h].x * kr[i].x + q[h].y * kr[i].y) * QSCALE; m = fmaxf(m, s[i]); }
        if (ext) { sx = wave_sum(q[h].x * kxr.x + q[h].y * kxr.y) * QSCALE; m = fmaxf(m, sx); }
        float l = 0.f; f32x2_t acc = {0.f, 0.f};
#pragma unroll
        for (int i = 0; i < NKW; ++i) { const float pp = __expf(s[i] - m); l += pp; acc += vr[i] * pp; }
        if (ext) { const float pp = __expf(sx - m); l += pp; acc += vxr * pp; }
        if (lane == 0) { pm[(w * NH + h) * 2] = m; pm[(w * NH + h) * 2 + 1] = l; }
        *(LAS f32x2_t*)(pa + (w * NH + h) * 128 + 2 * lane) = acc;
    }
    __syncthreads();
    if (w < NH) { const int h = w; const float sk = sinks ? sinks[h] : -1e30f; float M = sk;
#pragma unroll
        for (int ww = 0; ww < 8; ++ww) M = fmaxf(M, pm[(ww * NH + h) * 2]);
        float den = sinks ? __expf(sk - M) : 0.f; f32x2_t o = {0.f, 0.f};
#pragma unroll
        for (int ww = 0; ww < 8; ++ww) { const float f = __expf(pm[(ww * NH + h) * 2] - M); den += f * pm[(ww * NH + h) * 2 + 1]; o += *(const LAS f32x2_t*)(pa + (ww * NH + h) * 128 + 2 * lane) * f; }
        const float id = 1.0f / den; *(unsigned*)(op + 128 * h) = pk2(o.x * id, o.y * id); }
    __syncthreads();
}
__device__ __forceinline__ void ph_attn_sample(const Frame& F, const Args& a, int L, bool is_swa) {
    const int lane = F.lane, j = L / 2;
    const float* QKV = (const float*)(a.ws + WS_QKV); bf16* OCAT = (bf16*)(a.ws + WS_OCAT);
    const int pitch = is_swa ? SWA_IN : RET_IN, qoff = is_swa ? 2560 : 4608;
    const float* CMK = a.in[5] + (size_t)L * SB * 256 * 512; const float* CMV = a.in[6] + (size_t)L * SB * 256 * 512;
    const float* CK = a.in[2] + (size_t)j * SB * 128 * 512; const float* CV = a.in[3] + (size_t)j * SB * 128 * 512;
    const int n2 = is_swa ? SB * 4 : 0, n3 = n2 + SB * 4;
    for (int u = F.bid; u < n3; u += F.G) {
        if (u < n2) { const int kvh = u % 4, b = u / 4; const size_t row = (size_t)MP + b, co = ((size_t)b * 128) * 512 + kvh * 128 + 2 * lane;
            const float* kx = QKV + row * SWA_IN + 1536 + kvh * 128 + 2 * lane;
            decode_unit<3, 16, true>(F.lds, F.tid, QKV + row * SWA_IN + 3 * kvh * 128 + 2 * lane, CK + co, CV + co, kx, kx + 512, a.in[15] + j * 12 + 3 * kvh, OCAT + row * D + 3 * kvh * 128 + 2 * lane,
                                     a.out + O_SKS + (size_t)j * SB * 128 * 512 + co, a.out + O_SVS + (size_t)j * SB * 128 * 512 + co);
        } else { const int uu = u - n2, h = uu % 4, b = uu / 4; const size_t row = (size_t)MP + b, co = ((size_t)b * 256) * 512 + h * 128 + 2 * lane;
            decode_unit<1, 32, false>(F.lds, F.tid, QKV + row * pitch + qoff + h * 128 + 2 * lane, CMK + co, CMV + co, nullptr, nullptr, nullptr, OCAT + row * D + 1536 + h * 128 + 2 * lane, nullptr, nullptr);
        }
    }
}
__device__ __forceinline__ void ph_ret_r1(const Frame& F, const Args& a) {
    const bf16* QB = (const bf16*)(a.ws + WS_QKVB); float* DST = (float*)(a.ws + WS_DST);
    const int tid = F.tid, lane = F.lane, w = F.wave, r16 = lane & 15, g = lane >> 4, tq = r16 >> 2, tp = r16 & 3;
    LAS unsigned char* Kt = F.lds; LAS unsigned char* Vt = F.lds + 128 * KP;
    const bool bal = F.G == 256 && NB * 6 * 16 * 2 == 768;
    const int u2_0 = bal ? (F.bid < 128 ? F.bid : F.bid + 128) : F.bid, u2_s = bal ? 128 : F.G, u2_e = bal ? (F.bid < 128 ? 256 : 768) : NB * 6 * 16 * 2;
    for (int u2 = u2_0; u2 < u2_e; u2 += u2_s) {
        const int hf = u2 & 1, u = u2 >> 1, c = u % 16, h = (u / 16) % 6, b = u / 96; const size_t row0 = (size_t)b * SEQ + 128 * c;
        const float lg = log2f(1.0f - exp2f(-5.0f - (float)h));
        __syncthreads();
#pragma unroll
        for (int it = 0; it < 4; ++it) { const int row = it * 32 + (tid >> 4), ch = tid & 15;
            const v4u kv = *(const v4u*)(QB + (row0 + row) * RET_IN + 768 + h * 128 + ch * 8);
            const float f = exp2f((float)(127 - row) * lg);
            v4u o; o.x = pk2(bf2f(kv.x & 0xffff) * f, bf2f(kv.x >> 16) * f); o.y = pk2(bf2f(kv.y & 0xffff) * f, bf2f(kv.y >> 16) * f);
            o.z = pk2(bf2f(kv.z & 0xffff) * f, bf2f(kv.z >> 16) * f); o.w = pk2(bf2f(kv.w & 0xffff) * f, bf2f(kv.w >> 16) * f);
            *(LAS v4u*)(Kt + row * KP + ch * 16) = o;
            *(LAS v4u*)(Vt + row * KP + ch * 16) = *(const v4u*)(QB + (row0 + row) * RET_IN + 1536 + h * 256 + 128 * hf + ch * 8); }
        __syncthreads();
        f32x4 acc[8];
#pragma unroll
        for (int nt = 0; nt < 8; ++nt) acc[nt] = (f32x4){0.f, 0.f, 0.f, 0.f};
#pragma unroll
        for (int ks = 0; ks < 4; ++ks) {
            const bf16x8 af = frag_tr(Vt, 32 * ks + 8 * g, 32 * ks + 8 * g + 4, 16 * w, KP, tq, tp);
#pragma unroll
            for (int nt = 0; nt < 8; ++nt) { const bf16x8 bfr = frag_tr(Kt, 32 * ks + 8 * g, 32 * ks + 8 * g + 4, 16 * nt, KP, tq, tp); acc[nt] = MFMA16(af, bfr, acc[nt]); } }
        float* dp = DST + (size_t)u * 32768 + (size_t)(128 * hf + 16 * w + 4 * g) * 128 + r16;
#pragma unroll
        for (int nt = 0; nt < 8; ++nt)
#pragma unroll
            for (int r = 0; r < 4; ++r) dp[(size_t)r * 128 + 16 * nt] = acc[nt][r];
    }
    __syncthreads();
}
__device__ __forceinline__ void ph_ret_r2(const Frame& F, const Args& a, int jr) {
    const float* DST = (const float*)(a.ws + WS_DST); bf16* SC = (bf16*)(a.ws + WS_SC); float* so = a.out + O_RSP + (size_t)jr * NB * 6 * 32768;
    LAS float* tl = (LAS float*)(F.lds + RING_OFF);
    const int tid = F.tid, ntile = NB * 6 * 16;
    for (int t = F.bid; t < ntile; t += F.G) {
        const int bh = t >> 4, dv0 = (t & 15) * 16, h = bh % 6, e = dv0 * 128 + 4 * tid;
        const float cdec = exp2f(128.0f * log2f(1.0f - exp2f(-5.0f - (float)h)));
        f32x4 d[16];
#pragma unroll
        for (int c = 0; c < 16; ++c) d[c] = *(const f32x4*)(DST + ((size_t)bh * 16 + c) * 32768 + e);
        f32x4 S = {0.f, 0.f, 0.f, 0.f};
#pragma unroll
        for (int c = 0; c < 16; ++c) { uint2 o; o.x = pk2(S[0], S[1]); o.y = pk2(S[2], S[3]); *(uint2*)(SC + ((size_t)bh * 16 + c) * 32768 + e) = o; S = S * cdec + d[c]; }
        __syncthreads();
        { const int dvl = tid >> 5, dk = (tid & 31) * 4; LAS float* w = tl + dvl * 129 + dk; w[0] = S[0]; w[1] = S[1]; w[2] = S[2]; w[3] = S[3]; }
        __syncthreads();
#pragma unroll
        for (int k = 0; k < 4; ++k) { const int idx = tid + 512 * k, dk = idx >> 4, dvl = idx & 15; so[(size_t)bh * 32768 + (size_t)dk * 256 + dv0 + dvl] = tl[dvl * 129 + dk]; }
    }
    __syncthreads();
}
__device__ __forceinline__ void ph_ret_r3(const Frame& F, const Args& a) {
    const bf16* QB = (const bf16*)(a.ws + WS_QKVB); const bf16* SC = (const bf16*)(a.ws + WS_SC); bf16* OCAT = (bf16*)(a.ws + WS_OCAT);
    const int tid = F.tid, lane = F.lane, w = F.wave, r16 = lane & 15, g = lane >> 4, tq = r16 >> 2, tp = r16 & 3;
    LAS unsigned char* Kt = F.lds; LAS unsigned char* St = F.lds + 128 * KP; LAS unsigned char* Vt = F.lds + 128 * KP;
    for (int u = F.bid; u < NB * 6 * 16; u += F.G) {
        const int c = u % 16, h = (u / 16) % 6, b = u / 96; const size_t row0 = (size_t)b * SEQ + 128 * c;
        const float lg = log2f(1.0f - exp2f(-5.0f - (float)h));
        __syncthreads();
#pragma unroll
        for (int it = 0; it < 4; ++it) { const int row = it * 32 + (tid >> 4), ch = tid & 15;
            *(LAS v4u*)(Kt + row * KP + ch * 16) = *(const v4u*)(QB + (row0 + row) * RET_IN + 768 + h * 128 + ch * 8); }
#pragma unroll
        for (int it = 0; it < 8; ++it) { const int row = it * 32 + (tid >> 4), ch = tid & 15;
            *(LAS v4u*)(St + row * KP + ch * 16) = *(const v4u*)(SC + (size_t)u * 32768 + (size_t)row * 128 + ch * 8); }
        __syncthreads();
        const int ti = 16 * w + r16;
        const bf16* qp = QB + (row0 + ti) * RET_IN + h * 128 + 8 * g;
        bf16x8 qf[4];
#pragma unroll
        for (int ks = 0; ks < 4; ++ks) qf[ks] = *(const bf16x8*)(qp + 32 * ks);
        f32x4 s[8];
#pragma unroll
        for (int nt = 0; nt < 8; ++nt) { s[nt] = (f32x4){0.f, 0.f, 0.f, 0.f};
            if (nt <= w) {
#pragma unroll
                for (int ks = 0; ks < 4; ++ks) { const bf16x8 kf = *(const LAS bf16x8*)(Kt + (16 * nt + r16) * KP + (32 * ks + 8 * g) * 2); s[nt] = MFMA16(kf, qf[ks], s[nt]); }
#pragma unroll
                for (int r = 0; r < 4; ++r) { const int sk = 16 * nt + 4 * g + r; s[nt][r] = (sk <= ti) ? s[nt][r] * exp2f(-(float)(sk + 1) * lg) : 0.f; } } }
        f32x4 acc[16];
#pragma unroll
        for (int mt = 0; mt < 16; ++mt) { acc[mt] = (f32x4){0.f, 0.f, 0.f, 0.f};
#pragma unroll
            for (int ks = 0; ks < 4; ++ks) { const bf16x8 sf = *(const LAS bf16x8*)(St + (16 * mt + r16) * KP + (32 * ks + 8 * g) * 2); acc[mt] = MFMA16(sf, qf[ks], acc[mt]); } }
        __syncthreads();
#pragma unroll
        for (int it = 0; it < 8; ++it) { const int row = it * 16 + (tid >> 5), ch = tid & 31;
            *(LAS v4u*)(Vt + row * VP2 + ch * 16) = *(const v4u*)(QB + (row0 + row) * RET_IN + 1536 + h * 256 + ch * 8); }
        __syncthreads();
#pragma unroll
        for (int ks = 0; ks < 4; ++ks) {
            if (2 * ks <= w) {
                const bf16x8 pf = pack_bf8(s[2 * ks], s[2 * ks + 1]);
#pragma unroll
                for (int mt = 0; mt < 16; ++mt) { const bf16x8 vf = frag_tr(Vt, 32 * ks + 4 * g, 32 * ks + 16 + 4 * g, 16 * mt, VP2, tq, tp); acc[mt] = MFMA16(vf, pf, acc[mt]); } } }
        const float qd = exp2f((float)(ti + 1) * lg); float sum = 0.f;
#pragma unroll
        for (int mt = 0; mt < 16; ++mt) { acc[mt] = acc[mt] * qd; sum += (acc[mt][0] + acc[mt][1]) + (acc[mt][2] + acc[mt][3]); }
        sum += __shfl_xor(sum, 16); sum += __shfl_xor(sum, 32);
        const float mean = sum * (1.f / 256.f); float sq = 0.f;
#pragma unroll
        for (int mt = 0; mt < 16; ++mt) { acc[mt] = acc[mt] - mean; sq += (acc[mt][0] * acc[mt][0] + acc[mt][1] * acc[mt][1]) + (acc[mt][2] * acc[mt][2] + acc[mt][3] * acc[mt][3]); }
        sq += __shfl_xor(sq, 16); sq += __shfl_xor(sq, 32);
        const float rstd = 1.0f / sqrtf(sq * (1.f / 256.f) + HN_EPS);
        const bf16* gp = QB + (row0 + ti) * RET_IN + 3072 + h * 256 + 4 * g; bf16* op = OCAT + (row0 + ti) * D + h * 256 + 4 * g;
        uint2 gate[16];
#pragma unroll
        for (int mt = 0; mt < 16; ++mt) gate[mt] = *(const uint2*)(gp + 16 * mt);
#pragma unroll
        for (int mt = 0; mt < 16; ++mt) { const uint2 gg = gate[mt];
            uint2 o; o.x = pk2(silu_f(bf2f(gg.x & 0xffff)) * acc[mt][0] * rstd, silu_f(bf2f(gg.x >> 16)) * acc[mt][1] * rstd);
            o.y = pk2(silu_f(bf2f(gg.y & 0xffff)) * acc[mt][2] * rstd, silu_f(bf2f(gg.y >> 16)) * acc[mt][3] * rstd);
            *(uint2*)(op + 16 * mt) = o; }
    }
    __syncthreads();
}
__device__ __forceinline__ void ph_ret_sample(const Frame& F, const Args& a, int jr) {
    const float* QKV = (const float*)(a.ws + WS_QKV); float* ORAW = (float*)(a.ws + WS_ORAW);
    LAS float* qs = (LAS float*)(F.lds + RING_OFF); LAS float* ks = qs + 128; LAS float* po = qs + 256;
    const int dv = F.tid & 255, hf = F.tid >> 8;
    for (int u = F.G - 1 - F.bid; u < SB * 6; u += F.G) {
        const int seq = u / 6, h = u % 6; const size_t row = (size_t)MP + seq;
        const float* S0 = a.in[4] + (size_t)jr * SB * 6 * 32768; float* Sout = a.out + O_RSS + (size_t)jr * SB * 6 * 32768;
        const float gamma = 1.0f - exp2f(-5.0f - (float)h);
        const size_t so = (size_t)(seq * 6 + h) * 32768 + (size_t)(64 * hf) * 256 + dv;
        const float* p = QKV + row * RET_IN;
        __syncthreads();
        if (F.tid < 128) qs[F.tid] = p[h * 128 + F.tid]; else if (F.tid < 256) ks[F.tid - 128] = p[768 + h * 128 + (F.tid - 128)];
        const float v = p[1536 + h * 256 + dv];
        __syncthreads();
        float o = 0.f;
#pragma unroll
        for (int i0 = 0; i0 < 64; i0 += 32) {
            float s0[32];
#pragma unroll
            for (int j = 0; j < 32; ++j) s0[j] = S0[so + (size_t)(i0 + j) * 256];
#pragma unroll
            for (int j = 0; j < 32; ++j) { const int i = 64 * hf + i0 + j; const float sn = gamma * s0[j] + ks[i] * v; Sout[so + (size_t)(i0 + j) * 256] = sn; o += qs[i] * sn; }
        }
        if (hf) po[dv] = o;
        __syncthreads();
        if (!hf) ORAW[row * 1536 + h * 256 + dv] = o + po[dv];
    }
    __syncthreads();
}

#ifndef WBITS
#define WBITS 5
#endif
__device__ __forceinline__ unsigned f2bfw(float f) { constexpr unsigned sh = 23 - WBITS; unsigned u = __builtin_bit_cast(unsigned, f); u += ((1u << (sh - 1)) - 1u) + ((u >> sh) & 1u); return (u >> sh) << (sh - 16); }
__device__ __forceinline__ unsigned pkw(float lo, float hi) { return f2bfw(lo) | (f2bfw(hi) << 16); }
__device__ __forceinline__ void conv_load(float (&r)[64], const float* wu, int pitch, int lane) {
#pragma unroll
    for (int kk = 0; kk < 64; ++kk) r[kk] = __builtin_nontemporal_load((wu + (size_t)kk * pitch) + lane);
}
__device__ __forceinline__ void conv_proc(const float (&r)[64], LAS float* scr, int lane, bf16* wt, int K, const float* gain, const float* bias, float (&c1)[8], float& c2, bool coarse) {
#pragma unroll
    for (int kk = 0; kk < 64; ++kk) { float gk = 1.f; if (gain) { gk = gain[kk]; c2 += bias[kk] * r[kk]; } scr[kk * 65 + lane] = r[kk] * gk; }
    LDS_WAIT();
    const int c = lane & 7;
#pragma unroll
    for (int j = 0; j < 8; ++j) { const int n = (lane >> 3) + 8 * j; const LAS float* s = scr + (8 * c) * 65 + n;
        v4u o; if (coarse) { o.x = pkw(s[0 * 65], s[1 * 65]); o.y = pkw(s[2 * 65], s[3 * 65]); o.z = pkw(s[4 * 65], s[5 * 65]); o.w = pkw(s[6 * 65], s[7 * 65]); }
        else { o.x = pk2(s[0 * 65], s[1 * 65]); o.y = pk2(s[2 * 65], s[3 * 65]); o.z = pk2(s[4 * 65], s[5 * 65]); o.w = pk2(s[6 * 65], s[7 * 65]); }
        *(v4u*)(wt + (size_t)n * K + 8 * c) = o;
#pragma unroll
        for (int q = 0; q < 4; ++q) c1[j] += bf2f(o[q] & 0xffffu) + bf2f(o[q] >> 16); }
    LDS_WAIT();
}
__device__ __forceinline__ void conv_item(LAS float* scr, int lane, const float* W, int K, int pitch, int col0, bf16* WT, int row0, int kb0, int nkb, const float* gain, const float* bias, float* c1p, float* c2p, bool coarse) {
    float c1[8] = {0.f, 0.f, 0.f, 0.f, 0.f, 0.f, 0.f, 0.f}, c2 = 0.f;
    const float* wp = W + (size_t)(64 * kb0) * pitch + col0; bf16* wt = WT + (size_t)row0 * K + 64 * kb0;
    const float* gp = gain ? gain + 64 * kb0 : nullptr; const float* bp = gain ? bias + 64 * kb0 : nullptr;
    float ra[64], rb[64];
    conv_load(ra, wp, pitch, lane);
    for (int i = 0; i < nkb; i += 2) {
        const bool h1 = i + 1 < nkb, h2 = i + 2 < nkb;
        if (h1) conv_load(rb, wp + (size_t)64 * (i + 1) * pitch, pitch, lane);
        conv_proc(ra, scr, lane, wt + 64 * i, K, gp ? gp + 64 * i : nullptr, gp ? bp + 64 * i : nullptr, c1, c2, coarse);
        if (h1) { if (h2) conv_load(ra, wp + (size_t)64 * (i + 2) * pitch, pitch, lane);
            conv_proc(rb, scr, lane, wt + 64 * (i + 1), K, gp ? gp + 64 * (i + 1) : nullptr, gp ? bp + 64 * (i + 1) : nullptr, c1, c2, coarse); }
    }
    if (c1p) {
#pragma unroll
        for (int j = 0; j < 8; ++j) { float t = c1[j]; t += __shfl_xor(t, 1); t += __shfl_xor(t, 2); t += __shfl_xor(t, 4); c1[j] = t; }
        if ((lane & 7) == 0) {
#pragma unroll
            for (int j = 0; j < 8; ++j) c1p[(lane >> 3) + 8 * j] = c1[j]; }
        c2p[lane] = c2;
    }
}
__device__ __forceinline__ void ph_prologue(const Frame& F, const Args& a) {
    unsigned char* ws = a.ws; const int lane = F.lane;
    LAS float* scr = (LAS float*)(F.lds + RING_OFF + F.wave * 16640);
    constexpr int NB_GU = NGU / 64, NB_INS = SWA_IN / 64, NB_INR = RET_IN / 64;
    constexpr int N_BIG = 8 * NB_GU + 2 * NB_INS + 2 * NB_INR;
    constexpr int I_OUT = 4 * (D / 64) * 2, I_MEM = 4 * (1024 / 64) * 2, I_DN = 8 * (D / 64) * 32;
    constexpr int N_ALL = N_BIG + I_OUT + I_MEM + I_DN;
    bf16* Z0 = zbuf(ws, 0);
    for (size_t i = F.gtid; i < (size_t)MP * D / 4; i += F.ngt) { const float4 v = ((const float4*)a.in[0])[i]; uint2 o; o.x = pk2(v.x, v.y); o.y = pk2(v.z, v.w); ((uint2*)Z0)[i] = o; }
    for (size_t i = F.gtid; i < (size_t)SB * D / 4; i += F.ngt) { const float4 v = ((const float4*)a.in[1])[i]; uint2 o; o.x = pk2(v.x, v.y); o.y = pk2(v.z, v.w); ((uint2*)(Z0 + (size_t)MP * D))[i] = o; }
    for (size_t i = F.gtid; i < (size_t)1024 * D / 4; i += F.ngt) { const float4 v = ((const float4*)a.in[7])[i]; uint2 o; o.x = pk2(v.x, v.y); o.y = pk2(v.z, v.w); ((uint2*)(ws + WS_XMEMB))[i] = o; }
    { long long* st0 = stbuf(ws, 0); for (size_t i = F.gtid; i < (size_t)MP; i += F.ngt) { st0[2 * i] = 0; st0[2 * i + 1] = __float2ll_rn((float)D * (1.0f - LN_EPS) * ST_SCALE); }
      float* on = (float*)(ws + WS_ONES); for (size_t i = F.gtid; i < (size_t)2 * D; i += F.ngt) on[i] = i < (size_t)D ? 1.f : 0.f; }
    { float* rp = (float*)(ws + WS_ROPE);
      for (size_t i = F.gtid; i < (size_t)SEQ * 16; i += F.ngt) { const int pos = (int)(i >> 4), ii = (int)(i & 15); const float inv = powf(500000.0f, -(float)ii / 16.0f), ang = (float)pos * inv;
          float sn, cs; sincosf(ang, &sn, &cs); rp[2 * i] = cs; rp[2 * i + 1] = sn; }
      float* rr = (float*)(ws + WS_RETCS);
      for (size_t i = F.gtid; i < (size_t)SEQ * 64; i += F.ngt) { const int pos = (int)(i >> 6), ii = (int)(i & 63); const float an = powf(10000.0f, -((float)ii / 63.0f)), ang = (float)pos * an;
          float sn, cs; sincosf(ang, &sn, &cs); rr[2 * i] = cs; rr[2 * i + 1] = sn; } }
    unsigned* qword = (unsigned*)(ws + WS_CTL) + CW_Q;
    volatile LAS unsigned* tk = (volatile LAS unsigned*)(F.lds + LDSCTL_OFF + 64);
    for (;;) {
        __syncthreads();
        if (F.tid == 0) *tk = atomicAdd(qword, 8u);
        __syncthreads();
        const unsigned qb = *tk; if (qb >= (unsigned)N_ALL) break;
        const unsigned q = qb + (unsigned)F.wave; if (q >= (unsigned)N_ALL) continue;
        int r = (int)q;
        const float* W; int K = D, pitch, col0, row0, kb0 = 0, nkb = D / 64, v = 0; bf16* WT; float* c1p = nullptr; float* c2p = nullptr; bool coarse = true;
        if (r < N_BIG) {
            if (r < 8 * NB_GU) { const int m = r / NB_GU, nb = r % NB_GU, L = m >> 1, s = m & 1; v = 3 * L + (s ? 2 : 0);
                W = a.in[10] + (size_t)m * D * NGU; pitch = NGU; WT = (bf16*)(ws + WS_WGU) + (size_t)m * NGU * D; row0 = 64 * nb;
                const int pn = row0 >> 8, o = row0 & 255; col0 = o < 128 ? 128 * pn + o : DFF + 128 * pn + (o - 128);
                c1p = (float*)(ws + WS_C1GU) + (size_t)m * NGU + row0; c2p = c1p + (size_t)8 * NGU; }
            else if ((r -= 8 * NB_GU) < 2 * NB_INS) { const int m = r / NB_INS, nb = r % NB_INS; v = 3 * (2 * m) + 1; coarse = false;
                W = a.in[13] + (size_t)m * D * SWA_IN; pitch = SWA_IN; WT = (bf16*)(ws + WS_WINS) + (size_t)m * SWA_IN * D; row0 = 64 * nb; col0 = row0;
                c1p = (float*)(ws + WS_C1INS) + (size_t)m * SWA_IN + row0; c2p = c1p + (size_t)2 * SWA_IN; }
            else { r -= 2 * NB_INS; const int m = r / NB_INR, nb = r % NB_INR; v = 3 * (2 * m + 1) + 1; coarse = false;
                W = a.in[16] + (size_t)m * D * RET_IN; pitch = RET_IN; WT = (bf16*)(ws + WS_WINR) + (size_t)m * RET_IN * D; row0 = 64 * nb; col0 = row0;
                c1p = (float*)(ws + WS_C1INR) + (size_t)m * RET_IN + row0; c2p = c1p + (size_t)2 * RET_IN; }
        } else if ((r -= N_BIG) < I_OUT) { const int nb = r % (D / 64), kr = (r / (D / 64)) & 1, m = r / (2 * (D / 64));
            W = ((m & 1) ? a.in[17] : a.in[14]) + (size_t)(m >> 1) * D * D; pitch = D; WT = (bf16*)(ws + WS_WOUT) + (size_t)m * D * D; row0 = col0 = 64 * nb; kb0 = 16 * kr; nkb = 16;
        } else if ((r -= I_OUT) < I_MEM) { const int nb = r % (1024 / 64), kr = (r / (1024 / 64)) & 1, m = r / (2 * (1024 / 64)); coarse = false;
            W = a.in[12] + (size_t)m * D * 1024; pitch = 1024; WT = (bf16*)(ws + WS_WMEM) + (size_t)m * 1024 * D; row0 = col0 = 64 * nb; kb0 = 16 * kr; nkb = 16;
        } else { r -= I_MEM; const int nb = r % (D / 64), kr = (r / (D / 64)) & 31, m = r / (32 * (D / 64));
            W = a.in[11] + (size_t)m * DFF * D; K = DFF; pitch = D; WT = (bf16*)(ws + WS_WDN) + (size_t)m * D * DFF; row0 = col0 = 64 * nb; kb0 = kr < 24 ? 3 * kr : 72 + 2 * (kr - 24); nkb = kr < 24 ? 3 : 2;
        }
        conv_item(scr, lane, W, K, pitch, col0, WT, row0, kb0, nkb, v ? lngain(a, v) : nullptr, v ? lnbias(a, v) : nullptr, c1p, c2p, coarse);
    }
}

__device__ __forceinline__ void sample_stats(const Frame& F, const bf16* Zs, bool identity) {
    LAS f32x2_t* sst = (LAS f32x2_t*)(F.lds + SSTAT_OFF);
    const int row = F.tid >> 4, sub = F.tid & 15; float sum = 0.f, sq = 0.f;
#pragma unroll 4
    for (int i = 0; i < 16; ++i) { const v4u z = *(const v4u*)(Zs + (size_t)row * D + 8 * (sub + 16 * i));
#pragma unroll
        for (int q = 0; q < 4; ++q) { const float lo = bf2f(z[q] & 0xffffu), hi = bf2f(z[q] >> 16); sum += lo + hi; sq += lo * lo + hi * hi; } }
#pragma unroll
    for (int o = 1; o < 16; o <<= 1) { sum += __shfl_xor(sum, o); sq += __shfl_xor(sq, o); }
    const float mu = sum * (1.f / D), var = sq * (1.f / D) - mu * mu;
    __syncthreads();
    if (sub == 0) sst[row] = identity ? (f32x2_t){0.f, 1.f} : (f32x2_t){mu, 1.0f / sqrtf(fmaxf(var, 0.f) + LN_EPS)};
    __syncthreads();
}
struct SEpi { const float* c1; const float* c2; bf16* H; const bf16* Zo; bf16* Zn; const float* g; const float* b; float* QS; float s; int pad; };
template <int KIND> __device__ __forceinline__ void ph_sgemm(const Frame& F, const bf16* A, const bf16* Bt, int N, int K, const SEpi& E, int tf) {
    const int tid = F.tid, lane = F.lane, w = F.wave, r16 = lane & 15, g = lane >> 4;
    LAS float* red = (LAS float*)F.lds;
    const LAS f32x2_t* sst = (const LAS f32x2_t*)(F.lds + SSTAT_OFF);
    const int nitems = N / 32, kw = K / 8;
    for (int it = F.bid - tf; it < nitems; it += F.G - tf) {
        if (it < 0) break;
        int r0, r1; if (KIND == 0) { r0 = 256 * (it >> 3) + 16 * (it & 7); r1 = r0 + 128; } else { r0 = 32 * it; r1 = r0 + 16; }
        f32x4 acc[2][2];
#pragma unroll
        for (int m = 0; m < 2; ++m)
#pragma unroll
            for (int t = 0; t < 2; ++t) acc[m][t] = (f32x4){0.f, 0.f, 0.f, 0.f};
        const bf16* ap = A + (size_t)r16 * K + w * kw + 16 * g;
        const bf16* bp0 = Bt + (size_t)(r0 + r16) * K + w * kw + 16 * g; const bf16* bp1 = Bt + (size_t)(r1 + r16) * K + w * kw + 16 * g;
#pragma unroll 4
        for (int kc = 0; kc < kw; kc += 64) {
            bf16x8 af[2][2], bfr[2][2];
#pragma unroll
            for (int s2 = 0; s2 < 2; ++s2) { af[0][s2] = *(const bf16x8*)(ap + kc + 8 * s2); af[1][s2] = *(const bf16x8*)(ap + (size_t)16 * K + kc + 8 * s2);
                bfr[0][s2] = *(const bf16x8*)(bp0 + kc + 8 * s2); bfr[1][s2] = *(const bf16x8*)(bp1 + kc + 8 * s2); }
#pragma unroll
            for (int s2 = 0; s2 < 2; ++s2)
#pragma unroll
                for (int m = 0; m < 2; ++m)
#pragma unroll
                    for (int t = 0; t < 2; ++t) acc[m][t] = MFMA16(af[m][s2], bfr[t][s2], acc[m][t]);
        }
        __syncthreads();
#pragma unroll
        for (int m = 0; m < 2; ++m)
#pragma unroll
            for (int t = 0; t < 2; ++t)
#pragma unroll
                for (int r = 0; r < 4; ++r) red[(w * 32 + 16 * m + 4 * g + r) * 32 + 16 * t + r16] = acc[m][t][r];
        __syncthreads();
        const int row = tid >> 4, cp = tid & 15; float v0 = 0.f, v1 = 0.f;
#pragma unroll
        for (int ww = 0; ww < 8; ++ww) { v0 += red[(ww * 32 + row) * 32 + cp]; v1 += red[(ww * 32 + row) * 32 + 16 + cp]; }
        const f32x2_t st = sst[row];
        if (KIND == 0) {
            const float gg = st.y * (v0 - st.x * E.c1[r0 + cp]) + E.c2[r0 + cp], uu = st.y * (v1 - st.x * E.c1[r1 + cp]) + E.c2[r1 + cp];
            E.H[(size_t)row * DFF + 128 * (it >> 3) + 16 * (it & 7) + cp] = (bf16)f2bf(silu_f(gg) * uu);
        } else if (KIND == 1) {
#pragma unroll
            for (int t = 0; t < 2; ++t) { const int col = r0 + 16 * t + cp; const float zo = bf2f(E.Zo[(size_t)row * D + col]);
                E.Zn[(size_t)row * D + col] = (bf16)f2bf(ALPHA * ((zo - st.x) * st.y * E.g[col] + E.b[col]) + E.s * (t ? v1 : v0)); }
        } else {
            constexpr int N_ = KIND == 2 ? SWA_IN : RET_IN;
            float x0 = st.y * (v0 - st.x * E.c1[r0 + cp]) + E.c2[r0 + cp], x1 = st.y * (v1 - st.x * E.c1[r1 + cp]) + E.c2[r1 + cp];
            if (KIND == 2) {
                if (r0 < 2048 && (r0 & 127) == 0) {
                    const float inv = powf(500000.0f, -(float)cp / 16.0f); float sn, cs; sincosf((float)PAST * inv, &sn, &cs);
                    const float a0 = x0 * cs - x1 * sn, a1 = x1 * cs + x0 * sn; x0 = a0; x1 = a1; }
            } else {
                if (r0 < 1536) {
                    const float sc = r0 < 768 ? 1.0f : QSCALE;
#pragma unroll
                    for (int t = 0; t < 2; ++t) { float& x = t ? x1 : x0; const int col = r0 + 16 * t + cp; const float an = powf(10000.0f, -((float)((col & 127) >> 1) / 63.0f));
                        float sn, cs; sincosf((float)PAST * an, &sn, &cs); const float o = __shfl_xor(x, 1);
                        x = ((cp & 1) ? x * cs + o * sn : x * cs - o * sn) * sc; }
                }
            }
            E.QS[(size_t)row * N_ + r0 + cp] = x0; E.QS[(size_t)row * N_ + r1 + cp] = x1;
        }
    }
    __syncthreads();
}
__device__ __forceinline__ void ph_final(const Frame& F, const Args& a) {
    const bf16* Z = zbuf(a.ws, 12); const long long* st = stbuf(a.ws, 12); const float* g = lngain(a, 12); const float* b = lnbias(a, 12); const int lane = F.lane;
    f32x4 gv[4][2], bv[4][2];
#pragma unroll
    for (int j = 0; j < 4; ++j)
#pragma unroll
        for (int q = 0; q < 2; ++q) { gv[j][q] = *(const f32x4*)(g + 8 * (lane + 64 * j) + 4 * q); bv[j][q] = *(const f32x4*)(b + 8 * (lane + 64 * j) + 4 * q); }
    for (int r = F.gw; r < MR; r += F.ngw) {
        v4u z[4];
#pragma unroll
        for (int j = 0; j < 4; ++j) z[j] = *(const v4u*)(Z + (size_t)r * D + 8 * (lane + 64 * j));
        float mu, rs;
        if (r < MP) row_stats(st, r, mu, rs);
        else { float sum = 0.f, sq = 0.f;
#pragma unroll
            for (int j = 0; j < 4; ++j)
#pragma unroll
                for (int q = 0; q < 4; ++q) { const float lo = bf2f(z[j][q] & 0xffffu), hi = bf2f(z[j][q] >> 16); sum += lo + hi; sq += lo * lo + hi * hi; }
            sum = wave_sum(sum); sq = wave_sum(sq); mu = sum * (1.f / D); rs = 1.0f / sqrtf(fmaxf(sq * (1.f / D) - mu * mu, 0.f) + LN_EPS); }
#pragma unroll
        for (int j = 0; j < 4; ++j) { const int c = 8 * (lane + 64 * j); f32x4 o0, o1;
#pragma unroll
            for (int q = 0; q < 2; ++q) { o0[2 * q] = (bf2f(z[j][q] & 0xffffu) - mu) * rs * gv[j][0][2 * q] + bv[j][0][2 * q]; o0[2 * q + 1] = (bf2f(z[j][q] >> 16) - mu) * rs * gv[j][0][2 * q + 1] + bv[j][0][2 * q + 1];
                o1[2 * q] = (bf2f(z[j][2 + q] & 0xffffu) - mu) * rs * gv[j][1][2 * q] + bv[j][1][2 * q]; o1[2 * q + 1] = (bf2f(z[j][2 + q] >> 16) - mu) * rs * gv[j][1][2 * q + 1] + bv[j][1][2 * q + 1]; }
            float* op = a.out + O_YP + (size_t)r * D + c; *(f32x4*)op = o0; *(f32x4*)(op + 4) = o1; }
    }
}
__device__ __forceinline__ void ph_headnorm_gate(const Frame& F, const float* ORAW, const float* QKV, bf16* OCAT, int row_off, int rows) {
    const int lane = F.lane; const int nw = rows * 6;
    for (int w = F.gw; w < nw; w += F.ngw) {
        const int h = w % 6; const size_t row = (size_t)row_off + w / 6;
        const float4 o = *(const float4*)(ORAW + row * 1536 + h * 256 + 4 * lane);
        const float mean = wave_sum((o.x + o.y) + (o.z + o.w)) * (1.f / 256.f);
        const float dx = o.x - mean, dy = o.y - mean, dz = o.z - mean, dw = o.w - mean;
        const float rstd = 1.0f / sqrtf(wave_sum((dx * dx + dy * dy) + (dz * dz + dw * dw)) * (1.f / 256.f) + HN_EPS);
        const float4 g = *(const float4*)(QKV + row * RET_IN + 3072 + h * 256 + 4 * lane);
        uint2 p; p.x = pk2(silu_f(g.x) * dx * rstd, silu_f(g.y) * dy * rstd); p.y = pk2(silu_f(g.z) * dz * rstd, silu_f(g.w) * dw * rstd);
        *(uint2*)(OCAT + row * D + h * 256 + 4 * lane) = p;
    }
}

__device__ __forceinline__ Frame mkframe(LAS unsigned char* lds) {
    Frame F; int t = threadIdx.x; asm volatile("" : "+v"(t));
    F.lds = lds; F.tid = t; F.lane = t & 63; F.wave = __builtin_amdgcn_readfirstlane(t >> 6);
    F.G = gridDim.x; F.bid = blockIdx.x;
    F.gtid = (size_t)F.bid * NTHR + F.tid; F.ngt = (size_t)F.G * NTHR; F.gw = F.bid * NWAVES + F.wave; F.ngw = F.G * NWAVES;
    return F;
}
#define GRID_BAR() xcd_barrier(bar)
__device__ __forceinline__ void sub_barrier(unsigned* cnt, unsigned n) {
    asm volatile("s_waitcnt vmcnt(0)" ::: "memory");
    __syncthreads();
    if (threadIdx.x == 0) {
        __builtin_amdgcn_fence(__ATOMIC_RELEASE, "agent");
        asm volatile("s_waitcnt vmcnt(0)" ::: "memory");
        xb_add(cnt, 1u);
        unsigned sp = 0;
        while (xb_ld(cnt) < n) { __builtin_amdgcn_s_sleep(1); if (++sp > (1u << 22)) break; }
        __builtin_amdgcn_fence(__ATOMIC_ACQUIRE, "agent");
        asm volatile("s_waitcnt vmcnt(0)" ::: "memory");
    }
    __syncthreads();
}
template <class Epi> __device__ __forceinline__ void run_gemm(const Frame& F, const bf16* A, const bf16* Bt, int M, int N, int K, const Epi& E, int cshift) {
    pg8::Gemm g; g.A = A; g.Bt = Bt; g.M = M; g.N = N; g.K = K;
    pg8::StaticOrder S; S.init(M, N, F.G, (F.bid + cshift) % F.G);
    pg8::gemm_phase<Epi, pg8::StaticOrder, true, true>(F.lds + RING_OFF, g, S, E);
}
template <int S> __device__ __forceinline__ void ffn_step(const Args& a, LAS unsigned char* lds, const XcdBarrier& bar, int L, bool with_mem) {
    unsigned char* ws = a.ws; const Frame F = mkframe(lds);
    const int wi = 2 * L + S, v = 3 * L + (S ? 2 : 0);
    const bf16* Zc = zbuf(ws, v); bf16* Zn = zbuf(ws, v + 1); bf16* H = (bf16*)(ws + WS_H);
    const bf16* wgu = (const bf16*)(ws + WS_WGU) + (size_t)wi * NGU * D; const bf16* wdn = (const bf16*)(ws + WS_WDN) + (size_t)wi * D * DFF;
    const float* c1 = (const float*)(ws + WS_C1GU) + (size_t)wi * NGU; const float* c2 = c1 + (size_t)8 * NGU;
    { EpiGU E; E.H = H; E.st = stbuf(ws, v); E.c1 = c1; E.c2 = c2; run_gemm(F, Zc, wgu, MP, NGU, D, E, 0); }
    if (with_mem) { EpiMem E; E.out = a.out; E.MKB = (bf16*)(ws + WS_MEMKB); run_gemm(F, (const bf16*)(ws + WS_XMEMB), (const bf16*)(ws + WS_WMEM), 1024, 4096, D, E, F.G / 2); }
    const int tf = with_mem ? (3 * F.G) / 4 : F.G / 2;
    if (F.bid >= tf) { sample_stats(F, Zc + (size_t)MP * D, v == 0);
        { SEpi E{}; E.c1 = c1; E.c2 = c2; E.H = H + (size_t)MP * DFF; ph_sgemm<0>(F, Zc + (size_t)MP * D, wgu, NGU, D, E, tf); }
        sub_barrier((unsigned*)(ws + WS_CTL) + 1024 + 32 * wi, (unsigned)(F.G - tf));
        { SEpi E{}; E.Zo = Zc + (size_t)MP * D; E.Zn = Zn + (size_t)MP * D; E.g = lngain(a, v); E.b = lnbias(a, v); E.s = 0.5f; ph_sgemm<1>(F, H + (size_t)MP * DFF, wdn, D, DFF, E, tf); } }
    GRID_BAR();
    { EpiRes E; E.Zo = Zc; E.Zn = Zn; E.sto = stbuf(ws, v); E.stn = stbuf(ws, v + 1); E.g = lngain(a, v); E.b = lnbias(a, v); E.s = 0.5f; E.pad = 0; run_gemm(F, H, wdn, MP, D, DFF, E, 0); }
    GRID_BAR();
}
template <int L> __device__ __forceinline__ void layer(const Args& a, LAS unsigned char* lds, const XcdBarrier& bar) {
    constexpr int j = L / 2; constexpr bool is_swa = (L & 1) == 0; constexpr int nin = is_swa ? SWA_IN : RET_IN, v = 3 * L + 1;
    ffn_step<0>(a, lds, bar, L, L == 0);
    {
        unsigned char* ws = a.ws; const Frame F = mkframe(lds);
        const bf16* Zc = zbuf(ws, v); bf16* Zn = zbuf(ws, v + 1); float* QKV = (float*)(ws + WS_QKV); float* ORAW = (float*)(ws + WS_ORAW); bf16* OCAT = (bf16*)(ws + WS_OCAT);
        const bf16* win = is_swa ? (const bf16*)(ws + WS_WINS) + (size_t)j * SWA_IN * D : (const bf16*)(ws + WS_WINR) + (size_t)j * RET_IN * D;
        const float* c1 = is_swa ? (const float*)(ws + WS_C1INS) + (size_t)j * SWA_IN : (const float*)(ws + WS_C1INR) + (size_t)j * RET_IN; const float* c2 = c1 + 2 * nin;
        { EpiIn<is_swa ? 0 : 1> E; E.QB = (bf16*)(ws + WS_QKVB); E.st = stbuf(ws, v); E.c1 = c1; E.c2 = c2; E.rope = (const f32x4*)(ws + WS_ROPE); E.retcs = (const f32x4*)(ws + WS_RETCS); E.out = a.out; E.jl = j; E.pad = 0;
          run_gemm(F, Zc, win, MP, nin, D, E, 0); }
        if (F.bid >= F.G / 2) { sample_stats(F, Zc + (size_t)MP * D, false);
            SEpi E{}; E.c1 = c1; E.c2 = c2; E.QS = QKV + (size_t)MP * nin; ph_sgemm<is_swa ? 2 : 3>(F, Zc + (size_t)MP * D, win, nin, D, E, F.G / 2); }
        GRID_BAR();
        if (is_swa) {
            ph_attn_mfma(F, a, L, true, 0);
            ph_attn_sample(F, a, L, true);
        } else {
            ph_ret_r1(F, a);
            ph_attn_sample(F, a, L, false);
            GRID_BAR();
            ph_ret_r2(F, a, j);
            ph_ret_sample(F, a, j);
            GRID_BAR();
            ph_ret_r3(F, a);
            ph_attn_mfma(F, a, L, false, F.G / 2);
            ph_headnorm_gate(F, ORAW, QKV, OCAT, MP, SB);
        }
        GRID_BAR();
        const bf16* wout = (const bf16*)(ws + WS_WOUT) + (size_t)L * D * D;
        if (F.bid < D / 32 || F.G < D / 32) { sample_stats(F, Zc + (size_t)MP * D, false);
            SEpi E{}; E.Zo = Zc + (size_t)MP * D; E.Zn = Zn + (size_t)MP * D; E.g = lngain(a, v); E.b = lnbias(a, v); E.s = 1.0f; ph_sgemm<1>(F, OCAT + (size_t)MP * D, wout, D, D, E, 0); }
        { EpiRes E; E.Zo = Zc; E.Zn = Zn; E.sto = stbuf(ws, v); E.stn = stbuf(ws, v + 1); E.g = lngain(a, v); E.b = lnbias(a, v); E.s = 1.0f; E.pad = 0; run_gemm(F, OCAT, wout, MP, D, D, E, 0); }
        GRID_BAR();
    }
    ffn_step<1>(a, lds, bar, L, false);
}
__global__ void __launch_bounds__(NTHR, 2) mega(Args a) {
    extern __shared__ __attribute__((aligned(16))) unsigned char lds_raw[];
    LAS unsigned char* lds = (LAS unsigned char*)lds_raw;
    for (int u = threadIdx.x; u < (LDS_BYTES - LDSCTL_OFF) / 4; u += NTHR) ((LAS unsigned*)(lds + LDSCTL_OFF))[u] = 0u;
    __syncthreads();
    volatile LAS unsigned* MISC = (volatile LAS unsigned*)(lds + MISC_OFF);
    const XcdBarrier bar = xcd_barrier_post((unsigned*)(a.ws + WS_CTL) + CW_BAR, MISC + 8);
    { const Frame F = mkframe(lds); ph_prologue(F, a); GRID_BAR(); }
    layer<0>(a, lds, bar);
    layer<1>(a, lds, bar);
    layer<2>(a, lds, bar);
    layer<3>(a, lds, bar);
    { const Frame F = mkframe(lds); ph_final(F, a); }
}

extern "C" void kernel_launch(void* const* d_in, const int* in_sizes, int n_in, void* d_out, int out_size, void* d_ws, size_t ws_size, hipStream_t stream) {
    static int grid = 0;
    if (grid == 0) {
        if (n_in != 18 || (size_t)out_size != O_END || ws_size < WS_END) { fprintf(stderr, "kernel_launch: unexpected sizes n_in %d out %d ws %zu (need %zu)\n", n_in, out_size, ws_size, (size_t)WS_END); grid = -1; return; }
        int dev = 0, cus = 0, per_cu = 0;
        if (hipGetDevice(&dev) != hipSuccess || hipDeviceGetAttribute(&cus, hipDeviceAttributeMultiprocessorCount, dev) != hipSuccess) { grid = -1; return; }
        if (hipFuncSetAttribute((const void*)mega, hipFuncAttributeMaxDynamicSharedMemorySize, LDS_BYTES) != hipSuccess) { fprintf(stderr, "kernel_launch: hipFuncSetAttribute failed\n"); grid = -1; return; }
        if (hipOccupancyMaxActiveBlocksPerMultiprocessor(&per_cu, (const void*)mega, NTHR, LDS_BYTES) != hipSuccess || per_cu < 1) { fprintf(stderr, "kernel_launch: occupancy query says %d blocks per CU\n", per_cu); grid = -1; return; }
        (void)hipGetLastError();
        grid = cus;
    }
    if (grid < 0) return;
    if (hipMemsetAsync((char*)d_ws + WS_CTL, 0, CTL_BYTES, stream) != hipSuccess) { fprintf(stderr, "kernel_launch: memset failed\n"); return; }
    Args a{};
    for (int i = 0; i < 18; ++i) a.in[i] = (const float*)d_in[i];
    a.out = (float*)d_out; a.ws = (unsigned char*)d_ws;
    hipLaunchKernelGGL(mega, dim3(grid), dim3(NTHR), LDS_BYTES, stream, a);
}
```
